# Optimizing an MI355X kernel written in HIP

```python
import math
import jax, jax.numpy as jnp
from jax import lax
import numpy as np

D_MODEL = 2048
BATCH = 4
SEQ = 2048
DEPTH = 2

N_A = DEPTH // 2
N_B = DEPTH - N_A
GROUP_CH = 16
N_GROUPS = D_MODEL // GROUP_CH
STATE = 64
DT_MIN = 1e-3
DT_MAX = 1e-1
HEAD_DIM = 128
N_HEADS = D_MODEL // HEAD_DIM
BLOCK = 256
TOP_K_BLOCKS = 3
Q_CHUNK = 32
D_FF = int(math.ceil(8 * D_MODEL / 3 / 256) * 256)
EPS = 1e-6

kernel_name = "yoco_s5_moba_hybrid"


def rmsnorm(x, g):
    xf = x.astype(jnp.float32)
    y = xf * lax.rsqrt(jnp.mean(xf * xf, axis=-1, keepdims=True) + EPS)
    return (y * g.astype(jnp.float32)).astype(x.dtype)


def swiglu(u, w_gate, w_up, w_down):
    return (jax.nn.silu(u @ w_gate) * (u @ w_up)) @ w_down


def _ssm_combine(e1, e2):
    a1, b1 = e1
    a2, b2 = e2
    return a2 * a1, a2 * b1 + b2


def s5_mixer(u, lam_re, lam_im, log_dt, b_re, b_im, c_re, c_im, d_skip, w_glu, b_glu):
    bsz, L, D = u.shape
    f32 = jnp.float32
    lam = lax.complex(lam_re.astype(f32), lam_im.astype(f32))
    dt = jnp.exp(log_dt.astype(f32))[:, None]
    lam_bar = jnp.exp(lam * dt)
    b_c = lax.complex(b_re.astype(f32), b_im.astype(f32))
    b_bar = ((lam_bar - 1.0) / lam)[..., None] * b_c
    c_c = lax.complex(c_re.astype(f32), c_im.astype(f32))
    uf = u.astype(f32)
    ug = uf.reshape(bsz, L, N_GROUPS, GROUP_CH).astype(jnp.complex64)
    bu = jnp.einsum('blgc,gpc->blgp', ug, b_bar)
    a = jnp.broadcast_to(lam_bar, (1, L) + lam_bar.shape)
    _, states = lax.associative_scan(_ssm_combine, (a, bu), axis=1)
    y = jnp.einsum('blgp,gcp->blgc', states, c_c).real.reshape(bsz, L, D)
    y = y + d_skip.astype(f32) * uf
    z = jax.nn.gelu(y).astype(u.dtype)
    return z * jax.nn.sigmoid(z @ w_glu + b_glu)


def shared_kv(h, g_kv, w_kv):
    bsz, L, D = h.shape
    nb = -(-L // BLOCK)
    pad = nb * BLOCK - L
    kv = rmsnorm(h, g_kv) @ w_kv
    k, v = jnp.split(kv, 2, axis=-1)

    def to_blocks(t):
        t = jnp.pad(t, ((0, 0), (0, pad), (0, 0)))
        return t.reshape(bsz, nb, BLOCK, N_HEADS, HEAD_DIM).transpose(0, 3, 1, 2, 4)

    k_blocks = to_blocks(k)
    v_blocks = to_blocks(v)
    k_mean = jnp.mean(k_blocks.astype(jnp.float32), axis=3).astype(h.dtype)
    return k_blocks, v_blocks, k_mean


def alibi_slopes(n):
    return jnp.exp2(-8.0 * jnp.arange(1, n + 1, dtype=jnp.float32) / n)


def moba_attention(q, k_blocks, v_blocks, k_mean):
    bsz, H, L, Dh = q.shape
    nb = k_blocks.shape[2]
    k_sel = min(TOP_K_BLOCKS, nb)
    scale = Dh ** -0.5
    slopes = alibi_slopes(H)
    b_ix = jnp.arange(bsz)[:, None, None, None]
    h_ix = jnp.arange(H)[None, :, None, None]
    blk_ar = jnp.arange(BLOCK)

    def chunk(c):
        t0 = c * Q_CHUNK
        qc = lax.dynamic_slice_in_dim(q, t0, Q_CHUNK, axis=2)
        t = t0 + jnp.arange(Q_CHUNK)
        own = t0 // BLOCK
        gate = jnp.einsum('bhtd,bhnd->bhtn', qc, k_mean).astype(jnp.float32)
        gate = jnp.where(jnp.arange(nb) < own, gate, -jnp.inf)
        _, idx = lax.top_k(gate, k_sel)
        valid = jnp.arange(k_sel) < own
        k_g = k_blocks[b_ix, h_ix, idx]
        v_g = v_blocks[b_ix, h_ix, idx]
        s_sel = jnp.einsum('bhtd,bhtjsd->bhtjs', qc, k_g).astype(jnp.float32) * scale
        pos_sel = idx[..., None] * BLOCK + blk_ar
        dist_sel = (t[:, None, None] - pos_sel).astype(jnp.float32)
        s_sel = s_sel - slopes.reshape(1, H, 1, 1, 1) * dist_sel
        s_sel = jnp.where(valid[:, None], s_sel, -jnp.inf)
        k_own = lax.dynamic_slice_in_dim(k_blocks, own, 1, axis=2)[:, :, 0]
        v_own = lax.dynamic_slice_in_dim(v_blocks, own, 1, axis=2)[:, :, 0]
        s_own = jnp.einsum('bhtd,bhsd->bhts', qc, k_own).astype(jnp.float32) * scale
        dist_own = t[:, None] - (own * BLOCK + blk_ar)[None, :]
        s_own = jnp.where(dist_own >= 0,
                          s_own - slopes.reshape(1, H, 1, 1) * dist_own.astype(jnp.float32),
                          -jnp.inf)
        s_all = jnp.concatenate([s_sel.reshape(bsz, H, Q_CHUNK, k_sel * BLOCK), s_own], axis=-1)
        p = jax.nn.softmax(s_all, axis=-1).astype(q.dtype)
        p_sel = p[..., :k_sel * BLOCK].reshape(bsz, H, Q_CHUNK, k_sel, BLOCK)
        p_own = p[..., k_sel * BLOCK:]
        return (jnp.einsum('bhtjs,bhtjsd->bhtd', p_sel, v_g)
                + jnp.einsum('bhts,bhsd->bhtd', p_own, v_own))

    out = lax.map(chunk, jnp.arange(L // Q_CHUNK))
    return out.transpose(1, 0, 3, 2, 4).reshape(bsz, L, H * Dh)


def setup_inputs(seed: int = 0) -> dict:
    key = jax.random.key(seed)
    ks = jax.random.split(key, 24)
    D, F, G, P, C = D_MODEL, D_FF, N_GROUPS, STATE, GROUP_CH
    f32 = jnp.float32

    def nrm(k, shape, scale):
        return jax.random.normal(k, shape, f32) * scale

    x = jax.random.normal(ks[0], (BATCH, SEQ, D), f32)
    g_mix = 1.0 + nrm(ks[1], (DEPTH, D), 0.02)
    lambda_re = -0.5 + nrm(ks[2], (N_A, G, P), 0.01)
    lambda_im = jnp.pi * jnp.broadcast_to(jnp.arange(P, dtype=f32), (N_A, G, P)) + nrm(ks[3], (N_A, G, P), 0.01)
    log_dt = jax.random.uniform(ks[4], (N_A, G), f32, math.log(DT_MIN), math.log(DT_MAX))
    b_re = nrm(ks[5], (N_A, G, P, C), (2 * C) ** -0.5)
    b_im = nrm(ks[6], (N_A, G, P, C), (2 * C) ** -0.5)
    c_re = nrm(ks[7], (N_A, G, C, P), P ** -0.5)
    c_im = nrm(ks[8], (N_A, G, C, P), P ** -0.5)
    d_skip = nrm(ks[9], (N_A, D), 1.0)
    w_glu = nrm(ks[10], (N_A, D, D), D ** -0.5)
    b_glu = nrm(ks[11], (N_A, D), 0.02)
    g_kv = 1.0 + nrm(ks[12], (D,), 0.02)
    w_kv = nrm(ks[13], (D, 2 * D), D ** -0.5)
    w_q = nrm(ks[14], (N_B, D, D), D ** -0.5)
    w_o = nrm(ks[15], (N_B, D, D), D ** -0.5)
    g_ffn = 1.0 + nrm(ks[16], (DEPTH, D), 0.02)
    w_gate = nrm(ks[17], (DEPTH, D, F), D ** -0.5)
    w_up = nrm(ks[18], (DEPTH, D, F), D ** -0.5)
    w_down = nrm(ks[19], (DEPTH, F, D), F ** -0.5)
    g_final = 1.0 + nrm(ks[20], (D,), 0.02)
    return {"x": x, "g_mix": g_mix, "lambda_re": lambda_re, "lambda_im": lambda_im,
            "log_dt": log_dt, "b_re": b_re, "b_im": b_im, "c_re": c_re, "c_im": c_im,
            "d_skip": d_skip, "w_glu": w_glu, "b_glu": b_glu, "g_kv": g_kv, "w_kv": w_kv,
            "w_q": w_q, "w_o": w_o, "g_ffn": g_ffn, "w_gate": w_gate, "w_up": w_up,
            "w_down": w_down, "g_final": g_final}


def reference(x, g_mix, lambda_re, lambda_im, log_dt, b_re, b_im, c_re, c_im, d_skip, w_glu, b_glu,
              g_kv, w_kv, w_q, w_o, g_ffn, w_gate, w_up, w_down, g_final):
    bsz, L, D = x.shape
    h = x
    k_blocks = v_blocks = k_mean = None
    for i in range(DEPTH):
        u = rmsnorm(h, g_mix[i])
        if i < N_A:
            h = h + s5_mixer(u, lambda_re[i], lambda_im[i], log_dt[i], b_re[i], b_im[i],
                             c_re[i], c_im[i], d_skip[i], w_glu[i], b_glu[i])
        else:
            if i == N_A:
                k_blocks, v_blocks, k_mean = shared_kv(h, g_kv, w_kv)
            j = i - N_A
            q = (u @ w_q[j]).reshape(bsz, L, N_HEADS, HEAD_DIM).transpose(0, 2, 1, 3)
            h = h + moba_attention(q, k_blocks, v_blocks, k_mean) @ w_o[j]
        u = rmsnorm(h, g_ffn[i])
        h = h + swiglu(u, w_gate[i], w_up[i], w_down[i])
    return rmsnorm(h, g_final)
```

```cpp
#include <hip/hip_runtime.h>
#include <math.h>
#include <cstdio>

constexpr int D = 2048, BATCH = 4, SEQ = 2048, M = BATCH * SEQ, F = 5632, NG = 128, NP = 64, NC = 16, NH = 16, HD = 128, BLK = 256, NBLK = 8;
constexpr float EPS = 1e-6f;

__global__ __launch_bounds__(256) void rmsnorm_k(const float* x, const float* g, float* out) {
    const int row = blockIdx.x * 4 + (threadIdx.x >> 6), lane = threadIdx.x & 63;
    const float4* xr = (const float4*)(x + (size_t)row * D);
    const float4* gr = (const float4*)g;
    float4 v[8]; float s = 0.f;
#pragma unroll
    for (int j = 0; j < 8; ++j) { v[j] = xr[lane + 64 * j]; s += v[j].x * v[j].x + v[j].y * v[j].y + v[j].z * v[j].z + v[j].w * v[j].w; }
#pragma unroll
    for (int o = 32; o > 0; o >>= 1) s += __shfl_xor(s, o);
    const float r = 1.0f / sqrtf(s * (1.0f / D) + EPS);
    float4* orow = (float4*)(out + (size_t)row * D);
#pragma unroll
    for (int j = 0; j < 8; ++j) { const float4 gg = gr[lane + 64 * j]; float4 o; o.x = v[j].x * r * gg.x; o.y = v[j].y * r * gg.y; o.z = v[j].z * r * gg.z; o.w = v[j].w * r * gg.w; orow[lane + 64 * j] = o; }
}

__device__ __forceinline__ float gelu_tanh(float y) {
    const float k0 = 0.7978845608028654f, k1 = 0.044715f;
    const float t = tanhf(k0 * (y + k1 * y * y * y));
    return 0.5f * y * (1.f + t);
}

__global__ __launch_bounds__(64) void s5_naive_k(const float* __restrict__ u, const float* __restrict__ lam_re, const float* __restrict__ lam_im, const float* __restrict__ log_dt,
                                                const float* __restrict__ b_re, const float* __restrict__ b_im, const float* __restrict__ c_re, const float* __restrict__ c_im,
                                                const float* __restrict__ d_skip, float* __restrict__ z) {
    const int b = blockIdx.x / NG, g = blockIdx.x % NG, p = threadIdx.x;
    const float lr = lam_re[g * NP + p], li = lam_im[g * NP + p], dt = expf(log_dt[g]);
    const float e = expf(lr * dt); float sn, cs; sincosf(li * dt, &sn, &cs);
    const float lbr = e * cs, lbi = e * sn;
    const float nr = lbr - 1.f, ni = lbi, den = lr * lr + li * li;
    const float cfr = (nr * lr + ni * li) / den, cfi = (ni * lr - nr * li) / den;
    float Bbr[NC], Bbi[NC], Cr[NC], Ci[NC], dsk[NC];
#pragma unroll
    for (int c = 0; c < NC; ++c) {
        const float br = b_re[(g * NP + p) * NC + c], bi = b_im[(g * NP + p) * NC + c];
        Bbr[c] = cfr * br - cfi * bi; Bbi[c] = cfr * bi + cfi * br;
        Cr[c] = c_re[(g * NC + c) * NP + p]; Ci[c] = c_im[(g * NC + c) * NP + p];
        dsk[c] = d_skip[g * NC + c];
    }
    float sr = 0.f, si = 0.f;
    const float* ub = u + (size_t)b * SEQ * D + g * NC;
    float* zb = z + (size_t)b * SEQ * D + g * NC;
    for (int t = 0; t < SEQ; ++t) {
        float uc[NC];
#pragma unroll
        for (int c4 = 0; c4 < 4; ++c4) { const float4 v = *(const float4*)(ub + (size_t)t * D + 4 * c4); uc[4 * c4] = v.x; uc[4 * c4 + 1] = v.y; uc[4 * c4 + 2] = v.z; uc[4 * c4 + 3] = v.w; }
        float bur = 0.f, bui = 0.f;
#pragma unroll
        for (int c = 0; c < NC; ++c) { bur += Bbr[c] * uc[c]; bui += Bbi[c] * uc[c]; }
        const float nsr = lbr * sr - lbi * si + bur, nsi = lbr * si + lbi * sr + bui;
        sr = nsr; si = nsi;
        float yv = 0.f;
#pragma unroll
        for (int c = 0; c < NC; ++c) {
            float v = Cr[c] * sr - Ci[c] * si;
#pragma unroll
            for (int o = 32; o > 0; o >>= 1) v += __shfl_xor(v, o);
            if (p == c) yv = v + dsk[c] * uc[c];
        }
        if (p < NC) zb[(size_t)t * D + p] = gelu_tanh(yv);
    }
}

template <int MODE>
__global__ __launch_bounds__(256) void gemm_naive(const float* __restrict__ A, int lda, const float* __restrict__ W, const float* __restrict__ W2, int ldw, int K,
                                                  float* out, int ldo, const float* p0, const float* p1, const float* p2) {
    __shared__ float As[16][68];
    __shared__ float Ws[16][64];
    __shared__ float Ws2[16][64];
    const int tx = threadIdx.x & 15, ty = threadIdx.x >> 4;
    const int m0 = blockIdx.y * 64, n0 = blockIdx.x * 64;
    float acc[4][4] = {}, acc2[4][4] = {};
    for (int k0 = 0; k0 < K; k0 += 16) {
#pragma unroll
        for (int i = 0; i < 4; ++i) { const int e = threadIdx.x + 256 * i; const int r = e >> 4, c = e & 15; As[c][r] = A[(size_t)(m0 + r) * lda + k0 + c]; }
#pragma unroll
        for (int i = 0; i < 4; ++i) { const int e = threadIdx.x + 256 * i; const int r = e >> 6, c = e & 63; Ws[r][c] = W[(size_t)(k0 + r) * ldw + n0 + c]; if (MODE == 1) Ws2[r][c] = W2[(size_t)(k0 + r) * ldw + n0 + c]; }
        __syncthreads();
#pragma unroll
        for (int kk = 0; kk < 16; ++kk) {
            float a[4], bb[4], b2[4];
#pragma unroll
            for (int i = 0; i < 4; ++i) a[i] = As[kk][ty * 4 + i];
#pragma unroll
            for (int j = 0; j < 4; ++j) { bb[j] = Ws[kk][tx * 4 + j]; if (MODE == 1) b2[j] = Ws2[kk][tx * 4 + j]; }
#pragma unroll
            for (int i = 0; i < 4; ++i)
#pragma unroll
                for (int j = 0; j < 4; ++j) { acc[i][j] += a[i] * bb[j]; if (MODE == 1) acc2[i][j] += a[i] * b2[j]; }
        }
        __syncthreads();
    }
#pragma unroll
    for (int i = 0; i < 4; ++i)
#pragma unroll
        for (int j = 0; j < 4; ++j) {
            const int m = m0 + ty * 4 + i, n = n0 + tx * 4 + j; const size_t o = (size_t)m * ldo + n; float v;
            if (MODE == 0) { const float gate = acc[i][j] + p2[n]; const float zz = p1[o]; v = p0[o] + zz * (1.f / (1.f + expf(-gate))); }
            else if (MODE == 1) { const float gg = acc[i][j]; v = gg / (1.f + expf(-gg)) * acc2[i][j]; }
            else if (MODE == 2) v = p0[o] + acc[i][j];
            else v = acc[i][j];
            out[o] = v;
        }
}

__global__ __launch_bounds__(128) void kmean_k(const float* __restrict__ kv, float* __restrict__ kmean) {
    const int bhn = blockIdx.x, n = bhn % NBLK, h = (bhn / NBLK) % NH, b = bhn / (NBLK * NH), d = threadIdx.x;
    const float* kp = kv + ((size_t)b * SEQ + n * BLK) * (2 * D) + h * HD + d;
    float s = 0.f;
    for (int i = 0; i < BLK; ++i) s += kp[(size_t)i * 2 * D];
    kmean[(size_t)bhn * HD + d] = s * (1.f / BLK);
}

__global__ __launch_bounds__(64) void attn_naive_k(const float* __restrict__ q, const float* __restrict__ kv, const float* __restrict__ kmean, float* __restrict__ out) {
    __shared__ float qs[HD];
    __shared__ float ps[4 * BLK];
    const int lane = threadIdx.x;
    const int t = blockIdx.x % SEQ, h = (blockIdx.x / SEQ) % NH, b = blockIdx.x / (SEQ * NH);
    const int own = t / BLK;
    const float* qp = q + ((size_t)b * SEQ + t) * D + h * HD;
    qs[lane] = qp[lane]; qs[lane + 64] = qp[lane + 64];
    __syncthreads();
    float gate = -INFINITY;
    if (lane < own) { const float* km = kmean + (((size_t)b * NH + h) * NBLK + lane) * HD; float s = 0.f; for (int d = 0; d < HD; ++d) s += qs[d] * km[d]; gate = s; }
    float gv[NBLK];
#pragma unroll
    for (int n = 0; n < NBLK; ++n) gv[n] = __shfl(gate, n);
    unsigned selmask = 0u;
    const int ksel = own < 3 ? own : 3;
    for (int j = 0; j < ksel; ++j) {
        int best = -1; float bvv = -INFINITY;
#pragma unroll
        for (int n = 0; n < NBLK; ++n) if (n < own && gv[n] > bvv) { bvv = gv[n]; best = n; }
#pragma unroll
        for (int n = 0; n < NBLK; ++n) if (n == best) gv[n] = -INFINITY;
        selmask |= 1u << best;
    }
    selmask |= 1u << own;
    const float scale = 0.08838834764831845f;
    const float slope = exp2f(-8.0f * (float)(h + 1) / (float)NH);
    float mx = -INFINITY;
    int j = 0;
    for (int blk = 0; blk <= own; ++blk) {
        if (!((selmask >> blk) & 1u)) continue;
        for (int i = 0; i < 4; ++i) {
            const int s = lane + 64 * i, pos = blk * BLK + s;
            float sc = -INFINITY;
            if (pos <= t) {
                const float* kp = kv + ((size_t)b * SEQ + pos) * (2 * D) + h * HD; float dsum = 0.f;
                for (int d = 0; d < HD; d += 4) { const float4 k4 = *(const float4*)(kp + d); dsum += qs[d] * k4.x + qs[d + 1] * k4.y + qs[d + 2] * k4.z + qs[d + 3] * k4.w; }
                sc = dsum * scale - slope * (float)(t - pos);
            }
            ps[j * BLK + s] = sc; mx = fmaxf(mx, sc);
        }
        ++j;
    }
    const int nsel = j;
#pragma unroll
    for (int o = 32; o > 0; o >>= 1) mx = fmaxf(mx, __shfl_xor(mx, o));
    float sum = 0.f;
    for (int jj = 0; jj < nsel; ++jj)
        for (int i = 0; i < 4; ++i) { const int s = lane + 64 * i; const float e = expf(ps[jj * BLK + s] - mx); ps[jj * BLK + s] = e; sum += e; }
#pragma unroll
    for (int o = 32; o > 0; o >>= 1) sum += __shfl_xor(sum, o);
    __syncthreads();
    const float inv = 1.f / sum;
    float o0 = 0.f, o1 = 0.f;
    j = 0;
    for (int blk = 0; blk <= own; ++blk) {
        if (!((selmask >> blk) & 1u)) continue;
        const int lim = (blk == own) ? (t - own * BLK + 1) : BLK;
        const float* vp = kv + ((size_t)b * SEQ + blk * BLK) * (2 * D) + D + h * HD;
        for (int s = 0; s < lim; ++s) { const float pp = ps[j * BLK + s]; o0 += pp * vp[(size_t)s * 2 * D + lane]; o1 += pp * vp[(size_t)s * 2 * D + lane + 64]; }
        ++j;
    }
    float* op = out + ((size_t)b * SEQ + t) * D + h * HD;
    op[lane] = o0 * inv; op[lane + 64] = o1 * inv;
}

extern "C" void kernel_launch(void* const* d_in, const int* in_sizes, int n_in, void* d_out, int out_size, void* d_ws, size_t ws_size, hipStream_t stream) {
    const float* x = (const float*)d_in[0];
    const float* g_mix = (const float*)d_in[1];
    const float* lam_re = (const float*)d_in[2];
    const float* lam_im = (const float*)d_in[3];
    const float* log_dt = (const float*)d_in[4];
    const float* b_re = (const float*)d_in[5];
    const float* b_im = (const float*)d_in[6];
    const float* c_re = (const float*)d_in[7];
    const float* c_im = (const float*)d_in[8];
    const float* d_skip = (const float*)d_in[9];
    const float* w_glu = (const float*)d_in[10];
    const float* b_glu = (const float*)d_in[11];
    const float* g_kv = (const float*)d_in[12];
    const float* w_kv = (const float*)d_in[13];
    const float* w_q = (const float*)d_in[14];
    const float* w_o = (const float*)d_in[15];
    const float* g_ffn = (const float*)d_in[16];
    const float* w_gate = (const float*)d_in[17];
    const float* w_up = (const float*)d_in[18];
    const float* w_down = (const float*)d_in[19];
    const float* g_final = (const float*)d_in[20];
    float* h = (float*)d_out;
    const size_t MB = 1u << 20;
    const size_t need = (64 + 64 + 184 + 1) * MB;
    if (ws_size < need) { fprintf(stderr, "kernel_launch: workspace too small: %zu < %zu\n", ws_size, need); return; }
    char* ws = (char*)d_ws;
    float* R0 = (float*)ws;
    float* R1 = (float*)(ws + 64 * MB);
    float* R2 = (float*)(ws + 128 * MB);
    float* KM = (float*)(ws + 312 * MB);
    rmsnorm_k<<<M / 4, 256, 0, stream>>>(x, g_mix, R0);
    s5_naive_k<<<BATCH * NG, 64, 0, stream>>>(R0, lam_re, lam_im, log_dt, b_re, b_im, c_re, c_im, d_skip, R1);
    gemm_naive<0><<<dim3(D / 64, M / 64), 256, 0, stream>>>(R1, D, w_glu, nullptr, D, D, h, D, x, R1, b_glu);
    rmsnorm_k<<<M / 4, 256, 0, stream>>>(h, g_ffn, R0);
    gemm_naive<1><<<dim3(F / 64, M / 64), 256, 0, stream>>>(R0, D, w_gate, w_up, F, D, R2, F, nullptr, nullptr, nullptr);
    gemm_naive<2><<<dim3(D / 64, M / 64), 256, 0, stream>>>(R2, F, w_down, nullptr, D, F, h, D, h, nullptr, nullptr);
    rmsnorm_k<<<M / 4, 256, 0, stream>>>(h, g_kv, R0);
    gemm_naive<3><<<dim3(2 * D / 64, M / 64), 256, 0, stream>>>(R0, D, w_kv, nullptr, 2 * D, D, R2, 2 * D, nullptr, nullptr, nullptr);
    kmean_k<<<BATCH * NH * NBLK, 128, 0, stream>>>(R2, KM);
    rmsnorm_k<<<M / 4, 256, 0, stream>>>(h, g_mix + D, R0);
    gemm_naive<3><<<dim3(D / 64, M / 64), 256, 0, stream>>>(R0, D, w_q, nullptr, D, D, R1, D, nullptr, nullptr, nullptr);
    attn_naive_k<<<BATCH * NH * SEQ, 64, 0, stream>>>(R1, R2, KM, R0);
    gemm_naive<2><<<dim3(D / 64, M / 64), 256, 0, stream>>>(R0, D, w_o, nullptr, D, D, h, D, h, nullptr, nullptr);
    rmsnorm_k<<<M / 4, 256, 0, stream>>>(h, g_ffn + D, R0);
    gemm_naive<1><<<dim3(F / 64, M / 64), 256, 0, stream>>>(R0, D, w_gate + (size_t)D * F, w_up + (size_t)D * F, F, D, R2, F, nullptr, nullptr, nullptr);
    gemm_naive<2><<<dim3(D / 64, M / 64), 256, 0, stream>>>(R2, F, w_down + (size_t)F * D, nullptr, D, F, h, D, h, nullptr, nullptr);
    rmsnorm_k<<<M / 4, 256, 0, stream>>>(h, g_final, h);
}
```

```cpp
#include <hip/hip_runtime.h>
#include <cstdio>
#include <cstdint>
#include <math.h>

constexpr int DM = 2048, BATCH = 4, SEQ = 2048, MTOK = BATCH * SEQ, FF = 5632, NQKV = 3 * DM;
constexpr int NG = 128, NP = 64, NC = 16, NH = 16, HD = 128, BLK = 256, NBLK = 8;
constexpr float RMS_EPS = 1e-6f;
constexpr float QK_C2 = 0.08838834764831845f * 1.4426950408889634f;
namespace pg8 {
#define PG8_LAS __attribute__((address_space(3)))
typedef unsigned short bf16_t;
typedef short bf16x8 __attribute__((ext_vector_type(8)));
typedef float f32x4 __attribute__((ext_vector_type(4)));
typedef unsigned u32x4 __attribute__((ext_vector_type(4)));
constexpr int BM = 256, BK = 64, HALF = 128, HTB = HALF * BK * 2  , STAGE_BYTES = 8 * HTB, NXCD = 8, WGM = 8;

__host__ __device__ __forceinline__ int lds_byte(int r, int c) { const int st = (r >> 4) * 2 + (c >> 5), rr = r & 15, cc = c & 31, ob = rr * 64 + cc * 2; return st * 1024 + (ob ^ (((ob >> 9) & 1) << 5)); }
__host__ __device__ __forceinline__ void stage_rc(int b, int& R, int& C) { const int st = b / 1024, sb = b % 1024, swz = sb ^ (((sb >> 9) & 1) << 5); R = (st >> 1) * 16 + swz / 64; C = (st & 1) * 32 + (swz % 64) / 2; }
__host__ __device__ __forceinline__ int perm32(int rho) { const int n = rho >> 4, i = rho & 15; return 8 * (i >> 2) + 4 * n + (i & 3); }

struct Unit { int pm, pn; };
struct Gemm { const bf16_t* A; const bf16_t* Bt; int M, N, K; };

struct StaticOrder {
    int nM, nN, nwg, G, c;
    __host__ __device__ void init(int M, int N, int G_, int c_) { nM = M / BM; nN = N / BM; nwg = nM * nN; G = G_; c = c_; }
    __host__ __device__ bool next(int i, Unit& u) const {
        const long L = (long)i * G + c; if (L >= nwg) return false;
        int wgid = (int)L; { const int q = nwg / NXCD, r = nwg % NXCD, xcd = wgid % NXCD, off = wgid / NXCD; wgid = (xcd < r ? xcd * (q + 1) : r * (q + 1) + (xcd - r) * q) + off; }
        const int nig = WGM * nN, gid = wgid / nig, fm = gid * WGM, gsz = (nM - fm) < WGM ? (nM - fm) : WGM;
        u.pm = fm + ((wgid % nig) % gsz); u.pn = (wgid % nig) / gsz; return true;
    }
    __device__ __forceinline__ void a_ready(const Unit&) const {}
    __device__ __forceinline__ void done(const Unit&) const {}
};

__device__ __forceinline__ unsigned cvt_pk_bf16(float lo, float hi) { unsigned r; asm volatile("v_cvt_pk_bf16_f32 %0, %1, %2" : "=v"(r) : "v"(lo), "v"(hi)); return r; }
__device__ __forceinline__ float bf_lo(unsigned w) { return __uint_as_float(w << 16); }
__device__ __forceinline__ float bf_hi(unsigned w) { return __uint_as_float(w & 0xffff0000u); }
__device__ __forceinline__ float fast_sigmoid(float g) { return __builtin_amdgcn_rcpf(1.f + __builtin_amdgcn_exp2f(-1.4426950408889634f * g)); }
__device__ __forceinline__ float sq4(const f32x4 v) { return (v[0] * v[0] + v[1] * v[1]) + (v[2] * v[2] + v[3] * v[3]); }
__device__ __forceinline__ u32x4 pack8(const f32x4 a, const f32x4 b) { u32x4 w; w[0] = cvt_pk_bf16(a[0], a[1]); w[1] = cvt_pk_bf16(a[2], a[3]); w[2] = cvt_pk_bf16(b[0], b[1]); w[3] = cvt_pk_bf16(b[2], b[3]); return w; }
__device__ __forceinline__ void row_ss_add(float* ss, int r, float q, int fq) { q += __shfl_xor(q, 16); q += __shfl_xor(q, 32); if (fq == 0) atomicAdd(ss + r, q); }

struct EpiGlu {
    static constexpr bool PERM = true, AFTER_DRAIN = false;
    const float* x; const bf16_t* z; const float* bias; float* H; bf16_t* HB; float* ss;
    __device__ __forceinline__ void operator()(const f32x4 (&acc)[2][2][4][2], const Unit& u, int wr, int wc, int fr, int fq) const {
        const int row0 = u.pm * BM + wr * 64 + fr, col0 = u.pn * BM + wc * 32 + 8 * fq;
        f32x4 bv[2][2];
#pragma unroll
        for (int bj = 0; bj < 2; ++bj)
#pragma unroll
            for (int n = 0; n < 2; ++n) bv[bj][n] = *(const f32x4*)(bias + col0 + bj * HALF + 4 * n);
#pragma unroll
        for (int ai = 0; ai < 2; ++ai)
#pragma unroll
            for (int m = 0; m < 4; ++m) {
                const int r = row0 + ai * HALF + m * 16; const size_t off = (size_t)r * DM + col0; float q = 0.f;
#pragma unroll
                for (int bj = 0; bj < 2; ++bj) {
                    const size_t o = off + bj * HALF;
                    const f32x4 x0 = *(const f32x4*)(x + o), x1 = *(const f32x4*)(x + o + 4); const u32x4 zz = *(const u32x4*)(z + o);
                    const f32x4 g0 = acc[ai][bj][m][0] + bv[bj][0], g1 = acc[ai][bj][m][1] + bv[bj][1];
                    f32x4 h0, h1;
                    h0[0] = x0[0] + bf_lo(zz[0]) * fast_sigmoid(g0[0]); h0[1] = x0[1] + bf_hi(zz[0]) * fast_sigmoid(g0[1]);
                    h0[2] = x0[2] + bf_lo(zz[1]) * fast_sigmoid(g0[2]); h0[3] = x0[3] + bf_hi(zz[1]) * fast_sigmoid(g0[3]);
                    h1[0] = x1[0] + bf_lo(zz[2]) * fast_sigmoid(g1[0]); h1[1] = x1[1] + bf_hi(zz[2]) * fast_sigmoid(g1[1]);
                    h1[2] = x1[2] + bf_lo(zz[3]) * fast_sigmoid(g1[2]); h1[3] = x1[3] + bf_hi(zz[3]) * fast_sigmoid(g1[3]);
                    *(f32x4*)(H + o) = h0; *(f32x4*)(H + o + 4) = h1;
                    *(u32x4*)(HB + o) = pack8(h0, h1);
                    q += sq4(h0) + sq4(h1);
                }
                row_ss_add(ss, r, q, fq);
            }
    }
};

struct EpiSwiGLU {
    static constexpr bool PERM = true, AFTER_DRAIN = false;
    const float* ss; bf16_t* ACT;
    __device__ __forceinline__ void operator()(const f32x4 (&acc)[2][2][4][2], const Unit& u, int wr, int wc, int fr, int fq) const {
        const int row0 = u.pm * BM + wr * 64 + fr, col0 = u.pn * HALF + wc * 32 + 8 * fq;
#pragma unroll
        for (int ai = 0; ai < 2; ++ai)
#pragma unroll
            for (int m = 0; m < 4; ++m) {
                const int r = row0 + ai * HALF + m * 16;
                const float rs = 1.0f / sqrtf(ss[r] * (1.0f / DM) + RMS_EPS);
                f32x4 a[2];
#pragma unroll
                for (int n = 0; n < 2; ++n) {
                    const f32x4 g = acc[ai][0][m][n] * rs, uu = acc[ai][1][m][n] * rs;
#pragma unroll
                    for (int j = 0; j < 4; ++j) a[n][j] = g[j] * fast_sigmoid(g[j]) * uu[j];
                }
                *(u32x4*)(ACT + (size_t)r * FF + col0) = pack8(a[0], a[1]);
            }
    }
};

struct EpiRes {
    static constexpr bool PERM = true, AFTER_DRAIN = false;
    const float* base; float* H; bf16_t* HB; float* ss;
    __device__ __forceinline__ void operator()(const f32x4 (&acc)[2][2][4][2], const Unit& u, int wr, int wc, int fr, int fq) const {
        const int row0 = u.pm * BM + wr * 64 + fr, col0 = u.pn * BM + wc * 32 + 8 * fq;
#pragma unroll
        for (int ai = 0; ai < 2; ++ai)
#pragma unroll
            for (int m = 0; m < 4; ++m) {
                const int r = row0 + ai * HALF + m * 16; const size_t off = (size_t)r * DM + col0; float q = 0.f;
#pragma unroll
                for (int bj = 0; bj < 2; ++bj) {
                    const size_t o = off + bj * HALF;
                    const f32x4 h0 = *(const f32x4*)(base + o) + acc[ai][bj][m][0], h1 = *(const f32x4*)(base + o + 4) + acc[ai][bj][m][1];
                    *(f32x4*)(H + o) = h0; *(f32x4*)(H + o + 4) = h1;
                    if (HB) *(u32x4*)(HB + o) = pack8(h0, h1);
                    q += sq4(h0) + sq4(h1);
                }
                row_ss_add(ss, r, q, fq);
            }
    }
};

struct EpiQKV {
    static constexpr bool PERM = true, AFTER_DRAIN = false;
    const float* ss; bf16_t* QKV; float* kmean;
    __device__ __forceinline__ void operator()(const f32x4 (&acc)[2][2][4][2], const Unit& u, int wr, int wc, int fr, int fq) const {
        const int row0 = u.pm * BM + wr * 64 + fr, col0 = u.pn * BM + wc * 32 + 8 * fq;
        const bool isq = u.pn < 8, isk = (u.pn >= 8) && (u.pn < 16);
        const float qs = isq ? QK_C2 : 1.f;
        f32x4 ks[2][2];
#pragma unroll
        for (int bj = 0; bj < 2; ++bj)
#pragma unroll
            for (int n = 0; n < 2; ++n) ks[bj][n] = (f32x4){0.f, 0.f, 0.f, 0.f};
#pragma unroll
        for (int ai = 0; ai < 2; ++ai)
#pragma unroll
            for (int m = 0; m < 4; ++m) {
                const int r = row0 + ai * HALF + m * 16;
                const float rs = 1.0f / sqrtf(ss[r] * (1.0f / DM) + RMS_EPS);
                const float sc = rs * qs;
#pragma unroll
                for (int bj = 0; bj < 2; ++bj) {
                    const f32x4 v0 = acc[ai][bj][m][0] * sc, v1 = acc[ai][bj][m][1] * sc;
                    *(u32x4*)(QKV + (size_t)r * NQKV + col0 + bj * HALF) = pack8(v0, v1);
                    ks[bj][0] += v0; ks[bj][1] += v1;
                }
            }
        if (isk) {
#pragma unroll
            for (int bj = 0; bj < 2; ++bj)
#pragma unroll
                for (int n = 0; n < 2; ++n)
#pragma unroll
                    for (int j = 0; j < 4; ++j) {
                        float v = ks[bj][n][j];
                        v += __shfl_xor(v, 1); v += __shfl_xor(v, 2); v += __shfl_xor(v, 4); v += __shfl_xor(v, 8);
                        if (fr == 0) atomicAdd(kmean + (size_t)u.pm * DM + (col0 - DM) + bj * HALF + 4 * n + j, v * (1.0f / BLK));
                    }
        }
    }
};
template <class Epi, class Sched, bool ALIGN_EPI = false, bool SP2 = false>
__device__ __forceinline__ void gemm_phase(PG8_LAS unsigned char* lds, const Gemm g, const Sched& S, const Epi& E) {
    const int tid = threadIdx.x, wid = __builtin_amdgcn_readfirstlane(tid >> 6), lane = tid & 63, wr = wid >> 2, wc = wid & 3, fr = lane & 15, fq = lane >> 4;
    const int K = g.K, nt = K / BK;
    unsigned voffA[2], voffB[2];
#pragma unroll
    for (int i = 0; i < 2; ++i) { int R, C; stage_rc(tid * 16 + i * 8192, R, C); const int Rb = Epi::PERM ? ((R & ~31) + perm32(R & 31)) : R;
        voffA[i] = (unsigned)(R * K + C) * 2u; voffB[i] = (unsigned)(Rb * K + C) * 2u; }
    const size_t kstep = (size_t)(BK * 2);
    const size_t hstep = (size_t)HALF * K * 2;
    const size_t tstep = 2 * hstep;
    const unsigned ldsw = (unsigned)wid * 1024u;
    const int aoff = lds_byte(wr * 64 + fr, fq * 8), boff = lds_byte(wc * 32 + fr, fq * 8);
#define PG8_SA(b, h) (((b) * 2 + (h)) * HTB)
#define PG8_SB(b, h) ((4 + (b) * 2 + (h)) * HTB)
#define PG8_STAGE(bufoff, gbase, voff) do { _Pragma("unroll") for (int _i = 0; _i < 2; ++_i) \
        __builtin_amdgcn_global_load_lds((const unsigned*)((const char*)(gbase) + (voff)[_i]), (PG8_LAS unsigned*)(lds + (bufoff) + ldsw + _i * 8192), 16, 0, 0); } while (0)
#define PG8_LDA(dst, b, h) do { _Pragma("unroll") for (int m = 0; m < 4; ++m) _Pragma("unroll") for (int k = 0; k < 2; ++k) dst[m][k] = *(const PG8_LAS bf16x8*)(lds + PG8_SA(b, h) + aoff + m * 2048 + k * 1024); } while (0)
#define PG8_LDB(dst, b, h) do { _Pragma("unroll") for (int n = 0; n < 2; ++n) _Pragma("unroll") for (int k = 0; k < 2; ++k) dst[n][k] = *(const PG8_LAS bf16x8*)(lds + PG8_SB(b, h) + boff + n * 2048 + k * 1024); } while (0)
#define PG8_MMA(ai, bj, At, Bt) do { __builtin_amdgcn_s_setprio(1); _Pragma("unroll") for (int m = 0; m < 4; ++m) _Pragma("unroll") for (int n = 0; n < 2; ++n) _Pragma("unroll") for (int k = 0; k < 2; ++k) \
        acc[ai][bj][m][n] = __builtin_amdgcn_mfma_f32_16x16x32_bf16(Bt[n][k], At[m][k], acc[ai][bj][m][n], 0, 0, 0); __builtin_amdgcn_s_setprio(0); } while (0)
#define PG8_WAIT_V(n) asm volatile("s_waitcnt vmcnt(" #n ")" ::: "memory")
#define PG8_WAIT_L(n) asm volatile("s_waitcnt lgkmcnt(" #n ")" ::: "memory")
#define PG8_BAR __builtin_amdgcn_s_barrier()
#define PG8_SCHED __builtin_amdgcn_sched_barrier(0)
    Unit cur, nxt; int ui = 0;
    if (!S.next(0, cur)) return;
    f32x4 acc[2][2][4][2];
#pragma unroll
    for (int a = 0; a < 2; ++a)
#pragma unroll
        for (int b = 0; b < 2; ++b)
#pragma unroll
            for (int m = 0; m < 4; ++m)
#pragma unroll
                for (int n = 0; n < 2; ++n) acc[a][b][m][n] = (f32x4){0.f, 0.f, 0.f, 0.f};
    bf16x8 At[4][2], B0[2][2], B1[2][2];
    const char* cA = (const char*)g.A + (size_t)cur.pm * tstep; const char* cB = (const char*)g.Bt + (size_t)cur.pn * tstep;
    S.a_ready(cur);
    if constexpr (SP2) {
        PG8_STAGE(PG8_SB(0, 0), cB, voffB); PG8_STAGE(PG8_SB(0, 1), cB + hstep, voffB); PG8_STAGE(PG8_SA(0, 0), cA, voffA); PG8_STAGE(PG8_SA(0, 1), cA + hstep, voffA);
        if (wr == 1) PG8_BAR;
        PG8_WAIT_V(2); PG8_BAR;
        PG8_STAGE(PG8_SB(1, 0), cB + kstep, voffB); PG8_STAGE(PG8_SA(1, 0), cA + kstep, voffA); PG8_STAGE(PG8_SB(1, 1), cB + hstep + kstep, voffB);
        PG8_WAIT_V(6); PG8_BAR;
    } else {
        PG8_STAGE(PG8_SB(0, 0), cB, voffB); PG8_STAGE(PG8_SA(0, 0), cA, voffA); PG8_STAGE(PG8_SB(0, 1), cB + hstep, voffB); PG8_STAGE(PG8_SA(0, 1), cA + hstep, voffA);
        if (wr == 1) PG8_BAR;
        PG8_WAIT_V(4); PG8_BAR;
        PG8_STAGE(PG8_SB(1, 0), cB + kstep, voffB); PG8_STAGE(PG8_SA(1, 0), cA + kstep, voffA); PG8_STAGE(PG8_SB(1, 1), cB + hstep + kstep, voffB);
        PG8_WAIT_V(6); PG8_BAR;
    }
    for (;;) {
        const bool has_next = S.next(ui + 1, nxt);
        const char* nA = has_next ? (const char*)g.A + (size_t)nxt.pm * tstep : cA; const char* nB = has_next ? (const char*)g.Bt + (size_t)nxt.pn * tstep : cB;
        for (int t = 0; t < nt; t += 2) {
            const bool last = (t == nt - 2);
            const char* a1 = cA + (size_t)(t + 1) * kstep;
            const char* a2 = last ? nA : cA + (size_t)(t + 2) * kstep; const char* b2 = last ? nB : cB + (size_t)(t + 2) * kstep;
            const char* a3 = a2 + kstep; const char* b3 = b2 + kstep;
            if (last && has_next) S.a_ready(nxt);
            if constexpr (SP2) {
            PG8_LDB(B0, 0, 0); PG8_LDB(B1, 0, 1); PG8_SCHED; PG8_LDA(At, 0, 0); PG8_STAGE(PG8_SA(1, 1), a1 + hstep, voffA);
            PG8_WAIT_V(8); PG8_WAIT_L(0); PG8_BAR; PG8_MMA(0, 0, At, B0); PG8_MMA(0, 1, At, B1); PG8_BAR; PG8_SCHED;
            PG8_LDA(At, 0, 1); PG8_STAGE(PG8_SB(0, 0), b2, voffB); PG8_STAGE(PG8_SB(0, 1), b2 + hstep, voffB); PG8_STAGE(PG8_SA(0, 0), a2, voffA);
            PG8_WAIT_V(8); PG8_WAIT_L(0); PG8_BAR; PG8_MMA(1, 0, At, B0); PG8_MMA(1, 1, At, B1); PG8_BAR; PG8_SCHED;
            PG8_LDB(B0, 1, 0); PG8_LDB(B1, 1, 1); PG8_SCHED; PG8_LDA(At, 1, 0); PG8_STAGE(PG8_SA(0, 1), a2 + hstep, voffA);
            PG8_WAIT_V(8); PG8_WAIT_L(0); PG8_BAR; PG8_MMA(0, 0, At, B0); PG8_MMA(0, 1, At, B1); PG8_BAR; PG8_SCHED;
            PG8_LDA(At, 1, 1); PG8_STAGE(PG8_SB(1, 0), b3, voffB); PG8_STAGE(PG8_SB(1, 1), b3 + hstep, voffB); PG8_STAGE(PG8_SA(1, 0), a3, voffA);
            PG8_WAIT_V(8); PG8_WAIT_L(0); PG8_BAR; PG8_MMA(1, 0, At, B0); PG8_MMA(1, 1, At, B1); PG8_BAR; PG8_SCHED;
            } else {
            PG8_LDB(B0, 0, 0); PG8_SCHED; PG8_LDA(At, 0, 0); PG8_STAGE(PG8_SA(1, 1), a1 + hstep, voffA);
            PG8_WAIT_L(8); PG8_BAR; PG8_WAIT_L(0); PG8_MMA(0, 0, At, B0); PG8_BAR; PG8_SCHED;
            PG8_LDB(B1, 0, 1); PG8_STAGE(PG8_SB(0, 0), b2, voffB);
            PG8_BAR; PG8_WAIT_L(0); PG8_MMA(0, 1, At, B1); PG8_BAR;
            PG8_LDA(At, 0, 1); PG8_STAGE(PG8_SA(0, 0), a2, voffA);
            PG8_BAR; PG8_WAIT_L(0); PG8_MMA(1, 0, At, B0); PG8_BAR; PG8_SCHED;
            PG8_STAGE(PG8_SB(0, 1), b2 + hstep, voffB);
            PG8_WAIT_V(6); PG8_BAR; PG8_MMA(1, 1, At, B1); PG8_BAR;
            PG8_LDB(B0, 1, 0); PG8_SCHED; PG8_LDA(At, 1, 0); PG8_STAGE(PG8_SA(0, 1), a2 + hstep, voffA);
            PG8_WAIT_L(8); PG8_BAR; PG8_WAIT_L(0); PG8_MMA(0, 0, At, B0); PG8_BAR; PG8_SCHED;
            PG8_LDB(B1, 1, 1); PG8_STAGE(PG8_SB(1, 0), b3, voffB);
            PG8_BAR; PG8_WAIT_L(0); PG8_MMA(0, 1, At, B1); PG8_BAR;
            PG8_LDA(At, 1, 1); PG8_STAGE(PG8_SA(1, 0), a3, voffA);
            PG8_BAR; PG8_WAIT_L(0); PG8_MMA(1, 0, At, B0); PG8_BAR; PG8_SCHED;
            PG8_STAGE(PG8_SB(1, 1), b3 + hstep, voffB);
            PG8_WAIT_V(6); PG8_BAR; PG8_MMA(1, 1, At, B1); PG8_BAR;
            }
        }
        if constexpr (ALIGN_EPI) { if (wr == 0) PG8_BAR; }
        if constexpr (!Epi::AFTER_DRAIN) { E(acc, cur, wr, wc, fr, fq); S.done(cur); }
        if (!has_next) break;
#pragma unroll
        for (int a = 0; a < 2; ++a)
#pragma unroll
            for (int b = 0; b < 2; ++b)
#pragma unroll
                for (int m = 0; m < 4; ++m)
#pragma unroll
                    for (int n = 0; n < 2; ++n) acc[a][b][m][n] = (f32x4){0.f, 0.f, 0.f, 0.f};
        cur = nxt; cA = nA; cB = nB; ++ui;
        if constexpr (ALIGN_EPI) { if (wr == 1) PG8_BAR; }
    }
    PG8_WAIT_V(0);
    if constexpr (!ALIGN_EPI) { if (wr == 0) PG8_BAR; }
    PG8_BAR;
    if constexpr (Epi::AFTER_DRAIN) { E.fused(acc, cur, wr, wc, fr, fq, lds, wid, lane); S.done(cur); }
#undef PG8_SA
#undef PG8_SB
#undef PG8_STAGE
#undef PG8_LDA
#undef PG8_LDB
#undef PG8_MMA
#undef PG8_WAIT_V
#undef PG8_WAIT_L
#undef PG8_BAR
#undef PG8_SCHED
}
}
#define GAS __attribute__((address_space(1)))
#define LAS __attribute__((address_space(3)))
typedef unsigned short bf16;
typedef unsigned v4u __attribute__((ext_vector_type(4)));
typedef float f32x4 __attribute__((ext_vector_type(4)));
typedef short bf16x8 __attribute__((ext_vector_type(8)));
typedef GAS unsigned gu32;
typedef GAS unsigned long long gu64;
#define RLX_AGENT __ATOMIC_RELAXED, __HIP_MEMORY_SCOPE_AGENT
#define LDS_WAIT() asm volatile("s_waitcnt lgkmcnt(0)" ::: "memory")
#define VM_WAIT() asm volatile("s_waitcnt vmcnt(0)" ::: "memory")
__device__ __forceinline__ unsigned long long rt() { return __builtin_amdgcn_s_memrealtime(); }
__device__ __forceinline__ unsigned f2bf(float f) { unsigned u = __builtin_bit_cast(unsigned, f); return (u + 0x7fffu + ((u >> 16) & 1u)) >> 16; }
__device__ __forceinline__ unsigned pk2(float lo, float hi) { return f2bf(lo) | (f2bf(hi) << 16); }

#define XB_TMO      128
#define XB_XCNT(j)  (256  + 64 * (j))
#define XB_XSUB(j)  (1280 + 64 * (j))
#define XB_XGEN(j)  (2304 + 64 * (j))
#define XB_TOP      3328
#define XB_TOPGEN   3392
#define XCD_BAR_WORDS 3456
#define XB_SPIN_CAP (1u << 18)

__device__ __forceinline__ unsigned xb_ld(unsigned* p)              { return __hip_atomic_load(p, __ATOMIC_RELAXED, __HIP_MEMORY_SCOPE_AGENT); }
__device__ __forceinline__ unsigned xb_add(unsigned* p, unsigned v) { return __hip_atomic_fetch_add(p, v, __ATOMIC_RELAXED, __HIP_MEMORY_SCOPE_AGENT); }
__device__ __forceinline__ unsigned xb_xcc_id() { return (unsigned)__builtin_amdgcn_s_getreg((3 << 11) | 20) & 0xFu; }
#define XB_SPIN(cond, bar) do { unsigned _sp = 0; while (cond) { __builtin_amdgcn_s_sleep(1); \
    if ((++_sp & 255u) == 0u) { if (xb_ld(&(bar)[XB_TMO])) break; if (_sp > XB_SPIN_CAP) { atomicAdd(&(bar)[XB_TMO], 1u); break; } } } } while (0)

struct XcdBarrier {
    unsigned* bar; unsigned x;
    volatile LAS unsigned* st;
};

__device__ __forceinline__ XcdBarrier xcd_barrier_post(unsigned* bar, volatile LAS unsigned* st) {
    XcdBarrier b; b.bar = bar; b.x = xb_xcc_id(); b.st = st;
    if (threadIdx.x == 0) (void)xb_add(&bar[XB_XCNT(b.x)], 1u);
    return b;
}
__device__ __forceinline__ void xcd_barrier_complete(unsigned* bar, unsigned x, unsigned& nloc, unsigned& nx) {
    const unsigned G = gridDim.x * gridDim.y * gridDim.z;
    unsigned sum, cnt, mine, sp = 0u;
    for (;;) {
        sum = 0u; cnt = 0u; mine = 0u;
#pragma unroll
        for (unsigned j = 0; j < 16; ++j) { const unsigned c = xb_ld(&bar[XB_XCNT(j)]); sum += c; cnt += (c > 0u) ? 1u : 0u; mine = (j == x) ? c : mine; }
        if (sum == G) break;
        __builtin_amdgcn_s_sleep(1);
        if ((++sp & 255u) == 0u) { if (xb_ld(&bar[XB_TMO])) break; if (sp > XB_SPIN_CAP) { atomicAdd(&bar[XB_TMO], 1u); break; } }
    }
    nloc = mine > 0u ? mine : 1u; nx = cnt > 0u ? cnt : 1u;
}

__device__ __forceinline__ void xcd_barrier(const XcdBarrier& b) {
    asm volatile("s_waitcnt vmcnt(0)" ::: "memory");
    __syncthreads();
    if (threadIdx.x == 0) {
        unsigned* bar = b.bar;
        __builtin_amdgcn_s_waitcnt(0);
        unsigned nloc = b.st[0], nx = b.st[1];
        if (nloc == 0u) { xcd_barrier_complete(bar, b.x, nloc, nx); b.st[0] = nloc; b.st[1] = nx; }
        const unsigned old = xb_add(&bar[XB_XSUB(b.x)], 1u);
        const unsigned gen = old / nloc;
        if (old + 1u == (gen + 1u) * nloc) {
            __builtin_amdgcn_fence(__ATOMIC_RELEASE, "agent");
            asm volatile("s_waitcnt vmcnt(0)" ::: "memory");
            const unsigned og = xb_add(&bar[XB_TOP], 1u);
            const unsigned tg = og / nx;
            if (og + 1u == (tg + 1u) * nx) xb_add(&bar[XB_TOPGEN], 1u);
            else XB_SPIN(xb_ld(&bar[XB_TOPGEN]) == tg, bar);
            __builtin_amdgcn_fence(__ATOMIC_ACQUIRE, "agent");
            xb_add(&bar[XB_XGEN(b.x)], 1u);
            asm volatile("s_waitcnt vmcnt(0)" ::: "memory");
        } else {
            XB_SPIN(xb_ld(&bar[XB_XGEN(b.x)]) == gen, bar);
            __builtin_amdgcn_fence(__ATOMIC_ACQUIRE, "agent");
            asm volatile("s_waitcnt vmcnt(0)" ::: "memory");
        }
    }
    __syncthreads();
}
constexpr size_t MiB = 1u << 20;
constexpr size_t WS_CTL = 0, CTL_ZERO_BYTES = 2 * MiB;
constexpr size_t WS_SS = 1 * MiB;
constexpr size_t WS_KMEAN = WS_SS + 4 * MTOK * 4;
constexpr size_t WS_RSTD0 = WS_SS + 512 * 1024;
constexpr size_t WS_WGLU = 2 * MiB, WS_WQKV = 10 * MiB, WS_WO = 34 * MiB, WS_WGU0 = 42 * MiB, WS_WGU1 = 86 * MiB, WS_WD0 = 130 * MiB, WS_WD1 = 152 * MiB;
constexpr size_t WS_TAB = 174 * MiB;
constexpr size_t WS_H2 = WS_TAB;
constexpr size_t WS_HB = 238 * MiB;
constexpr size_t WS_X = 270 * MiB;
constexpr size_t WS_ACT = WS_X, WS_QKV = WS_X, WS_ATT = WS_X + 96 * MiB, WS_Z = WS_ATT;
constexpr size_t WS_END = WS_X + 128 * MiB;
static_assert(WS_KMEAN + (size_t)(MTOK / BLK) * DM * 4 <= WS_RSTD0 && WS_RSTD0 + MTOK * 4 <= CTL_ZERO_BYTES, "ctl map");
static_assert(WS_WD1 + (size_t)DM * FF * 2 <= WS_TAB && WS_H2 + (size_t)MTOK * DM * 4 <= WS_HB && WS_HB + (size_t)MTOK * DM * 2 <= WS_X && (size_t)MTOK * FF * 2 <= 96 * MiB, "ws map");
constexpr int CW_BAR = 4096;

constexpr int RING_OFF = 0, RING_BYTES = 131072;
constexpr int LDSCTL_OFF = RING_BYTES, MISC_OFF = LDSCTL_OFF + 320;
constexpr int LDS_BYTES = 147456;
constexpr int NWAVES = 8;

struct Args { const float* in[21]; float* out; unsigned char* ws; int ph_lo, ph_hi, li, pad; };

__device__ __forceinline__ float wave_sum(float v) {
#pragma unroll
    for (int o = 1; o < 64; o <<= 1) v += __shfl_xor(v, o);
    return v;
}

__device__ __forceinline__ void p0_transpose_item(const float* W, int K, int N, const float* g, bf16* WT, int mode, int row_off, LAS float* scr, int item, int lane) {
    const int nblk = N / 32, kb = item / nblk, nb = item % nblk, k0 = 64 * kb, n0 = 32 * nb;
    const int kk = lane >> 3, n4 = (lane & 7) * 4;
#pragma unroll
    for (int i = 0; i < 8; ++i) {
        const int k = 8 * i + kk;
        f32x4 v = *(const GAS f32x4*)(W + (size_t)(k0 + k) * N + n0 + n4);
        if (g) { const float gg = g[k0 + k]; v = v * gg; }
        LAS float* s = scr + k * 33 + n4;
        s[0] = v[0]; s[1] = v[1]; s[2] = v[2]; s[3] = v[3];
    }
    LDS_WAIT(); asm volatile("" ::: "memory");
    const int c = lane & 7;
#pragma unroll
    for (int j = 0; j < 4; ++j) {
        const int n = (lane >> 3) + 8 * j; const LAS float* s = scr + (8 * c) * 33 + n;
        v4u o; o.x = pk2(s[0 * 33], s[1 * 33]); o.y = pk2(s[2 * 33], s[3 * 33]); o.z = pk2(s[4 * 33], s[5 * 33]); o.w = pk2(s[6 * 33], s[7 * 33]);
        const int nn = n0 + n;
        const int row = mode == 0 ? row_off + nn : ((nn >> 7) * 256 + (mode == 2 ? 128 : 0) + (nn & 127));
        *(GAS v4u*)(WT + (size_t)row * K + k0 + 8 * c) = o;
    }
    LDS_WAIT(); asm volatile("" ::: "memory");
}

struct Ptrs {
    const float* in[21]; float* out; unsigned char* ws;
};

__device__ __forceinline__ void p0_prologue(const Ptrs& P, LAS unsigned char* lds, int vcu, int G, int wave, int lane) {
    LAS float* scr = (LAS float*)(lds + RING_OFF + wave * 16384);
    const int gw = vcu * NWAVES + wave, NGW = G * NWAVES;
    unsigned char* ws = P.ws;
    const float* g_mix = P.in[1]; const float* g_kv = P.in[12]; const float* g_ffn = P.in[16];
    constexpr int I_DD = (DM / 64) * (DM / 32), I_KV = (DM / 64) * (2 * DM / 32), I_GU = (DM / 64) * (FF / 32), I_DN = (FF / 64) * (DM / 32);
    constexpr int NITEMS = 3 * I_DD + I_KV + 4 * I_GU + 2 * I_DN;
    for (int it = gw; it < NITEMS; it += NGW) {
        int r = it;
        if (r < I_DD) { p0_transpose_item(P.in[10], DM, DM, nullptr, (bf16*)(ws + WS_WGLU), 0, 0, scr, r, lane); continue; } r -= I_DD;
        if (r < I_DD) { p0_transpose_item(P.in[14], DM, DM, g_mix + DM, (bf16*)(ws + WS_WQKV), 0, 0, scr, r, lane); continue; } r -= I_DD;
        if (r < I_KV) { p0_transpose_item(P.in[13], DM, 2 * DM, g_kv, (bf16*)(ws + WS_WQKV), 0, DM, scr, r, lane); continue; } r -= I_KV;
        if (r < I_DD) { p0_transpose_item(P.in[15], DM, DM, nullptr, (bf16*)(ws + WS_WO), 0, 0, scr, r, lane); continue; } r -= I_DD;
        if (r < I_GU) { p0_transpose_item(P.in[17], DM, FF, g_ffn, (bf16*)(ws + WS_WGU0), 1, 0, scr, r, lane); continue; } r -= I_GU;
        if (r < I_GU) { p0_transpose_item(P.in[18], DM, FF, g_ffn, (bf16*)(ws + WS_WGU0), 2, 0, scr, r, lane); continue; } r -= I_GU;
        if (r < I_GU) { p0_transpose_item(P.in[17] + (size_t)DM * FF, DM, FF, g_ffn + DM, (bf16*)(ws + WS_WGU1), 1, 0, scr, r, lane); continue; } r -= I_GU;
        if (r < I_GU) { p0_transpose_item(P.in[18] + (size_t)DM * FF, DM, FF, g_ffn + DM, (bf16*)(ws + WS_WGU1), 2, 0, scr, r, lane); continue; } r -= I_GU;
        if (r < I_DN) { p0_transpose_item(P.in[19], FF, DM, nullptr, (bf16*)(ws + WS_WD0), 0, 0, scr, r, lane); continue; } r -= I_DN;
        p0_transpose_item(P.in[19] + (size_t)FF * DM, FF, DM, nullptr, (bf16*)(ws + WS_WD1), 0, 0, scr, r, lane);
    }
    float* rstd0 = (float*)(ws + WS_RSTD0);
    for (int m = gw; m < MTOK; m += NGW) {
        const GAS f32x4* xr = (const GAS f32x4*)(P.in[0] + (size_t)m * DM) + lane; float s = 0.f;
#pragma unroll
        for (int j = 0; j < 8; ++j) { const f32x4 v = xr[64 * j]; s += (v.x * v.x + v.y * v.y) + (v.z * v.z + v.w * v.w); }
        s = wave_sum(s);
        if (lane == 0) rstd0[m] = 1.0f / sqrtf(s * (1.0f / DM) + RMS_EPS);
    }
}

__device__ __forceinline__ void p10_final(const Ptrs& P, int vcu, int G, int wave, int lane) {
    const int gw = vcu * NWAVES + wave, NGW = G * NWAVES;
    const float* H2 = (const float*)(P.ws + WS_H2); const float* ss4 = (const float*)(P.ws + WS_SS) + 3 * MTOK; const float* gf = P.in[20];
    f32x4 gv[8];
#pragma unroll
    for (int j = 0; j < 8; ++j) gv[j] = *((const GAS f32x4*)gf + lane + 64 * j);
    for (int m = gw; m < MTOK; m += NGW) {
        const float rs = 1.0f / sqrtf(ss4[m] * (1.0f / DM) + RMS_EPS);
        const GAS f32x4* hr = (const GAS f32x4*)(H2 + (size_t)m * DM) + lane; GAS f32x4* orow = (GAS f32x4*)(P.out + (size_t)m * DM) + lane;
#pragma unroll
        for (int j = 0; j < 8; ++j) orow[64 * j] = hr[64 * j] * rs * gv[j];
    }
}

constexpr int S5_TAB_AF = 0, S5_TAB_W1 = 32768, S5_TAB_W2 = 32768 + 131072, S5_TAB_LT = 32768 + 262144;
constexpr size_t S5_TAB_G = 32768 + 262144 + 1024;
constexpr int U_CH = 1040, LDS_U = 0;
constexpr int LDS_LF = 66560, LF_CH = 528;
constexpr int LDS_SP = LDS_LF + 64 * LF_CH, SP_CH = 272;
static_assert(64 * U_CH == LDS_LF && LDS_SP + 64 * SP_CH <= RING_BYTES && 64 * LF_CH >= 32768, "S5 LDS map");

typedef float f32x16 __attribute__((ext_vector_type(16)));
typedef unsigned u32x2 __attribute__((ext_vector_type(2)));
typedef float f32x2 __attribute__((ext_vector_type(2)));
__device__ __forceinline__ unsigned cvtpk(float lo, float hi) { unsigned r; asm volatile("v_cvt_pk_bf16_f32 %0, %1, %2" : "=v"(r) : "v"(lo), "v"(hi)); return r; }

__device__ __forceinline__ void p0_s5_tables(const Ptrs& P, LAS unsigned char* lds, int item, int tid) {
    const int g = item >> 1, half = item & 1;
    const float* lam_re = P.in[2] + g * NP; const float* lam_im = P.in[3] + g * NP;
    const float dt = expf(P.in[4][g]);
    LAS float* pwr = (LAS float*)lds; LAS float* pwi = pwr + 2148; LAS float* Bbr = pwi + 2148; LAS float* Bbi = Bbr + 1024; LAS float* Ccr = Bbi + 1024; LAS float* Cci = Ccr + 16 * 65;
    for (int e = tid; e < 33 * 64; e += 512) {
        const int ee = e >> 6, p = e & 63; const float lr = lam_re[p], li = lam_im[p];
        const float mag = expf((float)ee * lr * dt); float sn, cs; sincosf((float)ee * (li * dt), &sn, &cs);
        pwr[ee * 65 + p] = mag * cs; pwi[ee * 65 + p] = mag * sn;
    }
    for (int e = tid; e < 1024; e += 512) {
        { const int p = e >> 4; const float lr = lam_re[p], li = lam_im[p];
          const float mag = expf(lr * dt); float sn, cs; sincosf(li * dt, &sn, &cs);
          const float nr = mag * cs - 1.f, ni = mag * sn, den = lr * lr + li * li;
          const float cfr = (nr * lr + ni * li) / den, cfi = (ni * lr - nr * li) / den;
          const float br = P.in[5][(size_t)g * 1024 + e], bi = P.in[6][(size_t)g * 1024 + e];
          Bbr[e] = cfr * br - cfi * bi; Bbi[e] = cfr * bi + cfi * br; }
        { const int co = e >> 6, p = e & 63; Ccr[co * 65 + p] = P.in[7][(size_t)g * 1024 + e]; Cci[co * 65 + p] = P.in[8][(size_t)g * 1024 + e]; }
    }
    LDS_WAIT(); __syncthreads();
    unsigned char* tab = P.ws + WS_TAB + (size_t)g * S5_TAB_G;
    if (tid < 256) {
        const int tau = 16 * half + (tid >> 4), co = tid & 15;
        float acc[16];
#pragma unroll
        for (int c = 0; c < 16; ++c) acc[c] = 0.f;
        for (int p = 0; p < 64; ++p) {
            const float cr = Ccr[co * 65 + p], ci = Cci[co * 65 + p], pr = pwr[tau * 65 + p], pi = pwi[tau * 65 + p];
            const float xr = cr * pr - ci * pi, xi = cr * pi + ci * pr;
#pragma unroll
            for (int c4 = 0; c4 < 4; ++c4) {
                const f32x4 b_r = *(const LAS f32x4*)(Bbr + p * 16 + 4 * c4), b_i = *(const LAS f32x4*)(Bbi + p * 16 + 4 * c4);
#pragma unroll
                for (int j = 0; j < 4; ++j) acc[4 * c4 + j] += xr * b_r[j] - xi * b_i[j];
            }
        }
        v4u w[2];
#pragma unroll
        for (int h = 0; h < 2; ++h) { w[h].x = cvtpk(acc[8 * h], acc[8 * h + 1]); w[h].y = cvtpk(acc[8 * h + 2], acc[8 * h + 3]); w[h].z = cvtpk(acc[8 * h + 4], acc[8 * h + 5]); w[h].w = cvtpk(acc[8 * h + 6], acc[8 * h + 7]); }
#pragma unroll
        for (int h = 0; h < 2; ++h) {
            if (tau + 1 < 32) *(GAS v4u*)(tab + S5_TAB_AF + ((size_t)((tau + 1) * 64 + h * 32 + co)) * 16) = w[h];
            *(GAS v4u*)(tab + S5_TAB_AF + ((size_t)(tau * 64 + h * 32 + 16 + co)) * 16) = w[h];
            if (tau == 0) *(GAS v4u*)(tab + S5_TAB_AF + ((size_t)(h * 32 + co)) * 16) = (v4u){0u, 0u, 0u, 0u};
        }
        if (half == 0 && tid < 64) { f32x2 lt; lt.x = pwr[32 * 65 + tid]; lt.y = pwi[32 * 65 + tid]; *(GAS f32x2*)(tab + S5_TAB_LT + tid * 8) = lt; }
    } else if (half == 0) {
        for (int e = tid - 256; e < 2048; e += 256) {
            const int p = e >> 5, s = e & 31; const float pr = pwr[(31 - s) * 65 + p], pi = pwi[(31 - s) * 65 + p];
            float tr[16], ti[16];
#pragma unroll
            for (int c = 0; c < 16; ++c) { const float br = Bbr[p * 16 + c], bi = Bbi[p * 16 + c]; tr[c] = pr * br - pi * bi; ti[c] = pr * bi + pi * br; }
            const int Mt = p >> 4, r0 = 2 * (p & 15);
#pragma unroll
            for (int h = 0; h < 2; ++h) {
                v4u wr_, wi_;
                wr_.x = cvtpk(tr[8 * h], tr[8 * h + 1]); wr_.y = cvtpk(tr[8 * h + 2], tr[8 * h + 3]); wr_.z = cvtpk(tr[8 * h + 4], tr[8 * h + 5]); wr_.w = cvtpk(tr[8 * h + 6], tr[8 * h + 7]);
                wi_.x = cvtpk(ti[8 * h], ti[8 * h + 1]); wi_.y = cvtpk(ti[8 * h + 2], ti[8 * h + 3]); wi_.z = cvtpk(ti[8 * h + 4], ti[8 * h + 5]); wi_.w = cvtpk(ti[8 * h + 6], ti[8 * h + 7]);
                unsigned char* fb = tab + S5_TAB_W1 + ((size_t)((Mt * 32 + s) * 64 + h * 32 + r0)) * 16;
                *(GAS v4u*)(fb) = wr_; *(GAS v4u*)(fb + 16) = wi_;
            }
        }
    } else {
        for (int e = tid - 256; e < 8192; e += 256) {
            const int h = e & 1, ks = (e >> 1) & 7, co = (e >> 4) & 15, j = e >> 8;
            float v[8];
#pragma unroll
            for (int pp = 0; pp < 4; ++pp) {
                const int p = 8 * ks + 4 * h + pp;
                const float cr = Ccr[co * 65 + p], ci = Cci[co * 65 + p], pr = pwr[(j + 1) * 65 + p], pi = pwi[(j + 1) * 65 + p];
                v[2 * pp] = cr * pr - ci * pi; v[2 * pp + 1] = -(cr * pi + ci * pr);
            }
            v4u w; w.x = cvtpk(v[0], v[1]); w.y = cvtpk(v[2], v[3]); w.z = cvtpk(v[4], v[5]); w.w = cvtpk(v[6], v[7]);
            *(GAS v4u*)(tab + S5_TAB_W2 + ((size_t)(((j >> 1) * 8 + ks) * 64 + h * 32 + (j & 1) * 16 + co)) * 16) = w;
        }
    }
    __syncthreads();
}

__device__ __forceinline__ float gelu_tanh_fast(float y) { return y * __builtin_amdgcn_rcpf(1.f + __builtin_amdgcn_exp2f(-1.4426950408889634f * 1.5957691216057308f * (y + 0.044715f * y * y * y))); }
#define MFMA32(a, b, c) __builtin_amdgcn_mfma_f32_32x32x16_bf16((a), (b), (c), 0, 0, 0)

__device__ __forceinline__ void p1_s5(const Ptrs& P, LAS unsigned char* lds, int vcu, int G, int tid, int wave, int lane) {
    const int r32 = lane & 31, hi = lane >> 5;
    const float* rstd0 = (const float*)(P.ws + WS_RSTD0);
    bf16* Z = (bf16*)(P.ws + WS_Z);
    for (int it = vcu; it < BATCH * NG; it += G) {
        const int b = it / NG, g = it % NG;
        const unsigned char* tab = P.ws + WS_TAB + (size_t)g * S5_TAB_G;
        {
            const int qd = tid & 3; const float* xb = P.in[0] + (size_t)b * SEQ * DM + g * 16 + qd * 4; const float* rs = rstd0 + b * SEQ;
            const f32x4 gm = *(const GAS f32x4*)(P.in[1] + g * 16 + qd * 4);
#pragma unroll 8
            for (int i = 0; i < 16; ++i) {
                const int t = i * 128 + (tid >> 2);
                f32x4 v = *(const GAS f32x4*)(xb + (size_t)t * DM); const float r = rs[t];
                v = v * gm * r;
                u32x2 w; w.x = cvtpk(v[0], v[1]); w.y = cvtpk(v[2], v[3]);
                *(LAS u32x2*)(lds + LDS_U + (t >> 5) * U_CH + (t & 31) * 32 + qd * 8) = w;
            }
        }
        LDS_WAIT(); __syncthreads();
        {
            const int Mt = wave >> 1, nt = wave & 1;
            const unsigned char* w1 = tab + S5_TAB_W1 + (size_t)(Mt * 32) * 1024 + lane * 16;
            const LAS unsigned char* ub = lds + LDS_U + (nt * 32 + r32) * U_CH + hi * 16;
            f32x16 acc;
#pragma unroll
            for (int r = 0; r < 16; ++r) acc[r] = 0.f;
            bf16x8 a[8];
#pragma unroll
            for (int i = 0; i < 8; ++i) a[i] = *(const GAS bf16x8*)(w1 + i * 1024);
#pragma unroll
            for (int s0 = 0; s0 < 32; s0 += 8) {
#pragma unroll
                for (int i = 0; i < 8; ++i) {
                    const bf16x8 bf = *(const LAS bf16x8*)(ub + (s0 + i) * 32);
                    acc = MFMA32(a[i], bf, acc);
                    if (s0 + 8 + i < 32) a[i] = *(const GAS bf16x8*)(w1 + (s0 + 8 + i) * 1024);
                }
            }
            const int k = nt * 32 + r32;
#pragma unroll
            for (int rq = 0; rq < 4; ++rq) { f32x4 v; v[0] = acc[4 * rq]; v[1] = acc[4 * rq + 1]; v[2] = acc[4 * rq + 2]; v[3] = acc[4 * rq + 3];
                *(LAS f32x4*)(lds + LDS_LF + k * LF_CH + (32 * Mt + 8 * rq + 4 * hi) * 4) = v; }
        }
        v4u afr[4];
#pragma unroll
        for (int i = 0; i < 4; ++i) afr[i] = *(const GAS v4u*)(tab + S5_TAB_AF + (size_t)(i * 512 + tid) * 16);
        LDS_WAIT(); __syncthreads();
        if (wave == 0) {
            const f32x2 lt = *(const GAS f32x2*)(tab + S5_TAB_LT + lane * 8);
            float sr = 0.f, si = 0.f;
#pragma unroll 8
            for (int k = 0; k < 64; ++k) {
                const f32x2 L = *(const LAS f32x2*)(lds + LDS_LF + k * LF_CH + lane * 8);
                *(LAS unsigned*)(lds + LDS_SP + k * SP_CH + lane * 4) = cvtpk(sr, si);
                const float nr = lt.x * sr - lt.y * si + L.x, ni = lt.x * si + lt.y * sr + L.y;
                sr = nr; si = ni;
            }
        }
        LDS_WAIT(); __syncthreads();
#pragma unroll
        for (int i = 0; i < 4; ++i) *(LAS v4u*)(lds + LDS_LF + (i * 512 + tid) * 16) = afr[i];
        LDS_WAIT(); __syncthreads();
        const f32x4 dsk0 = *(const GAS f32x4*)(P.in[9] + g * 16 + 4 * hi), dsk1 = *(const GAS f32x4*)(P.in[9] + g * 16 + 8 + 4 * hi);
#pragma unroll 1
        for (int jj = 0; jj < 2; ++jj) {
            const int J = jj == 0 ? wave : 15 - wave;
            const unsigned char* w2 = tab + S5_TAB_W2 + (size_t)(J * 8) * 1024 + lane * 16;
            bf16x8 a2[8];
#pragma unroll
            for (int ks = 0; ks < 8; ++ks) a2[ks] = *(const GAS bf16x8*)(w2 + ks * 1024);
            f32x16 acc0, acc1;
#pragma unroll
            for (int r = 0; r < 16; ++r) { acc0[r] = 0.f; acc1[r] = 0.f; }
            const LAS unsigned char* afb = lds + LDS_LF + lane * 16;
            const LAS unsigned char* ub0 = lds + LDS_U + r32 * U_CH + hi * 16;
            const int n = 2 * J + 2;
#pragma unroll 2
            for (int s = 0; s < n; ++s) {
                const bf16x8 af = *(const LAS bf16x8*)(afb + (n - 1 - s) * 1024);
                const bf16x8 b0 = *(const LAS bf16x8*)(ub0 + s * 32), b1 = *(const LAS bf16x8*)(ub0 + 32 * U_CH + s * 32);
                acc0 = MFMA32(af, b0, acc0); acc1 = MFMA32(af, b1, acc1);
            }
            const LAS unsigned char* sp0 = lds + LDS_SP + r32 * SP_CH + hi * 16;
#pragma unroll
            for (int ks = 0; ks < 8; ++ks) {
                const bf16x8 b0 = *(const LAS bf16x8*)(sp0 + ks * 32), b1 = *(const LAS bf16x8*)(sp0 + 32 * SP_CH + ks * 32);
                acc0 = MFMA32(a2[ks], b0, acc0); acc1 = MFMA32(a2[ks], b1, acc1);
            }
#pragma unroll
            for (int nt = 0; nt < 2; ++nt) {
                const int k = nt * 32 + r32;
#pragma unroll
                for (int rq = 0; rq < 4; ++rq) {
                    const int jl = rq >> 1, co = 8 * (rq & 1) + 4 * hi, tl = 2 * J + jl;
                    const u32x2 uu = *(const LAS u32x2*)(lds + LDS_U + k * U_CH + tl * 32 + co * 2);
                    const f32x4 dk = (rq & 1) ? dsk1 : dsk0;
                    float y[4];
#pragma unroll
                    for (int i = 0; i < 4; ++i) y[i] = nt ? acc1[4 * rq + i] : acc0[4 * rq + i];
                    y[0] += dk[0] * __uint_as_float(uu.x << 16); y[1] += dk[1] * __uint_as_float(uu.x & 0xffff0000u);
                    y[2] += dk[2] * __uint_as_float(uu.y << 16); y[3] += dk[3] * __uint_as_float(uu.y & 0xffff0000u);
                    u32x2 w; w.x = cvtpk(gelu_tanh_fast(y[0]), gelu_tanh_fast(y[1])); w.y = cvtpk(gelu_tanh_fast(y[2]), gelu_tanh_fast(y[3]));
                    *(GAS u32x2*)(Z + ((size_t)(b * SEQ + k * 32 + tl)) * DM + g * 16 + co) = w;
                }
            }
        }
        LDS_WAIT(); __syncthreads();
    }
}
namespace att {
constexpr int PITCH = NQKV;
constexpr int SHM_K = 16384, SHM_V = 16384;
constexpr int A_V = 0, A_K = 2 * SHM_V, A_WS = 2 * SHM_V + 2 * SHM_K, A_BYTES = A_WS + 8 * 256;
static_assert(A_BYTES <= RING_BYTES, "attention LDS");
constexpr float THR2 = 11.5415603f;
#define KSWZ(row, colB) ((row) * 256 + ((colB) ^ (((row) & 7) << 4)))
#define SBAR() __builtin_amdgcn_sched_barrier(0)
__device__ __forceinline__ int v_st(int k, int c) { const int kk = (k & ~0xC) | ((k & 4) << 1) | ((k & 8) >> 1); return ((kk >> 3) * 4 + (c >> 5)) * 512 + ((kk & 7) * 32 + (c & 31)) * 2; }
__device__ __forceinline__ int v_rd_base(int lane) { return ((lane & 3) << 3) | (((lane >> 2) & 3) << 6) | (((lane >> 4) & 1) << 5) | (((lane >> 5) & 1) << 8); }
constexpr int v_rd_off(int d0, int ks, int half) { return d0 * 512 + ks * 4096 + half * 2048; }
__device__ __forceinline__ int crow(int r, int hi) { return (r & 3) + 8 * (r >> 2) + 4 * hi; }
typedef short s16x4 __attribute__((ext_vector_type(4)));

__device__ __forceinline__ void mask_tile(f32x16& p0, f32x16& p1, int dq) {
    const float NEG = -__builtin_inff();
#pragma unroll
    for (int r = 0; r < 16; ++r) { const int c = (r & 3) + 8 * (r >> 2); if (dq - c < 0) p0[r] = NEG; if (dq - c - 32 < 0) p1[r] = NEG; }
}
__device__ __forceinline__ void partialSM(f32x16& p0, f32x16& p1, float& m_reg, float& mn, float& alpha) {
    float pmax = p0[0];
#pragma unroll
    for (int r = 1; r < 16; ++r) pmax = fmaxf(pmax, p0[r]);
#pragma unroll
    for (int r = 0; r < 16; ++r) pmax = fmaxf(pmax, p1[r]);
    { auto rr = __builtin_amdgcn_permlane32_swap(__float_as_uint(pmax), __float_as_uint(pmax), false, false); pmax = fmaxf(__uint_as_float(rr[0]), __uint_as_float(rr[1])); }
    if (__builtin_expect(__all((pmax - m_reg) <= THR2), 1)) { mn = m_reg; alpha = 1.f; }
    else { mn = fmaxf(m_reg, pmax); alpha = __builtin_amdgcn_exp2f(m_reg - mn); m_reg = mn; }
#pragma unroll
    for (int r = 0; r < 16; ++r) p0[r] = p0[r] - mn;
#pragma unroll
    for (int r = 0; r < 16; ++r) p1[r] = p1[r] - mn;
#pragma unroll
    for (int r = 0; r < 16; ++r) p0[r] = __builtin_amdgcn_exp2f(p0[r]);
}
__device__ __forceinline__ void finishSM(f32x16& p0, f32x16& p1, float alpha, float& l_reg, bf16x8& pa0, bf16x8& pa1, bf16x8& pa2, bf16x8& pa3) {
#pragma unroll
    for (int r = 0; r < 16; ++r) p1[r] = __builtin_amdgcn_exp2f(p1[r]);
    float ps = 0.f;
#pragma unroll
    for (int r = 0; r < 16; ++r) ps += p0[r];
#pragma unroll
    for (int r = 0; r < 16; ++r) ps += p1[r];
    { auto rr = __builtin_amdgcn_permlane32_swap(__float_as_uint(ps), __float_as_uint(ps), false, false); ps = __uint_as_float(rr[0]) + __uint_as_float(rr[1]); }
    l_reg = l_reg * alpha + ps;
#define PK4(P, B_, OUT) do { unsigned a0 = cvtpk(P[B_ + 0], P[B_ + 1]), a1 = cvtpk(P[B_ + 2], P[B_ + 3]); unsigned b0 = cvtpk(P[B_ + 4], P[B_ + 5]), b1 = cvtpk(P[B_ + 6], P[B_ + 7]); \
        auto r0 = __builtin_amdgcn_permlane32_swap(a0, b0, false, false); auto r1 = __builtin_amdgcn_permlane32_swap(a1, b1, false, false); \
        v4u w = {r0[0], r1[0], r0[1], r1[1]}; OUT = __builtin_bit_cast(bf16x8, w); } while (0)
    PK4(p0, 0, pa0); PK4(p0, 8, pa1); PK4(p1, 0, pa2); PK4(p1, 8, pa3);
#undef PK4
}
template <int KB>
__device__ __forceinline__ void qkt(f32x16& p0, f32x16& p1, const LAS unsigned char* K_lds, int r32, int hi, const bf16x8* qr, float base0, float slope2) {
#pragma unroll
    for (int r = 0; r < 16; ++r) { const int c = (r & 3) + 8 * (r >> 2); p0[r] = fmaf(slope2, (float)c, base0); p1[r] = fmaf(slope2, (float)(c + 32), base0); }
    const LAS unsigned char* kb[4];
#pragma unroll
    for (int dd = 0; dd < 4; ++dd) kb[dd] = K_lds + KB * SHM_K + KSWZ(r32, (dd * 16 + hi * 8) * 2);
#pragma unroll
    for (int d0 = 0; d0 < 8; ++d0) { const LAS unsigned char* a = kb[d0 & 3] + (d0 >> 2) * 128;
        const bf16x8 b0 = *(const LAS bf16x8*)(a);
        const bf16x8 b1 = *(const LAS bf16x8*)(a + 32 * 256);
        p0 = MFMA32(b0, qr[d0], p0);
        p1 = MFMA32(b1, qr[d0], p1); }
}
template <int VB>
__device__ __forceinline__ void pv_tile(f32x16* o, int vb0, bf16x8 pa0, bf16x8 pa1, bf16x8 pa2, bf16x8 pa3) {
#define TRRD(dst, off) asm volatile("ds_read_b64_tr_b16 %0, %1 offset:%2" : "=&v"(dst) : "v"(vb0), "i"(off) : "memory")
#define PV_D0(d0) do { s16x4 l0, l1, l2, l3, h0, h1, h2, h3; constexpr int b_ = VB * SHM_V + v_rd_off(d0, 0, 0); \
        TRRD(l0, b_); TRRD(h0, b_ + 2048); TRRD(l1, b_ + 4096); TRRD(h1, b_ + 6144); TRRD(l2, b_ + 8192); TRRD(h2, b_ + 10240); TRRD(l3, b_ + 12288); TRRD(h3, b_ + 14336); \
        asm volatile("s_waitcnt lgkmcnt(0)" ::: "memory"); SBAR(); \
        o[d0] = MFMA32(pa0, ((bf16x8){l0[0], l0[1], l0[2], l0[3], h0[0], h0[1], h0[2], h0[3]}), o[d0]); \
        o[d0] = MFMA32(pa1, ((bf16x8){l1[0], l1[1], l1[2], l1[3], h1[0], h1[1], h1[2], h1[3]}), o[d0]); \
        o[d0] = MFMA32(pa2, ((bf16x8){l2[0], l2[1], l2[2], l2[3], h2[0], h2[1], h2[2], h2[3]}), o[d0]); \
        o[d0] = MFMA32(pa3, ((bf16x8){l3[0], l3[1], l3[2], l3[3], h3[0], h3[1], h3[2], h3[3]}), o[d0]); } while (0)
    PV_D0(0); PV_D0(1); PV_D0(2); PV_D0(3);
#undef PV_D0
#undef TRRD
}

__device__ __forceinline__ void moba_block(const bf16* Qg, const bf16* Kg, const bf16* Vg, bf16* Og, const float* km, int qb, float slope2, LAS unsigned char* lds, int tid, int wid, int lane) {
    const int r32 = lane & 31, hi = lane >> 5;
    const int NT = 4 * (qb + 1);
    LAS unsigned char* V_lds = lds + A_V; LAS unsigned char* K_lds = lds + A_K;
    LAS float* wsf = (LAS float*)(lds + A_WS) + wid * 64; LAS float* li_l = wsf; LAS float* al_l = wsf + 32;
    const int sr = tid >> 4, sc = (tid & 15) * 8, vst0 = v_st(sr, sc), vst1 = v_st(32 + sr, sc), kws = KSWZ(sr, sc * 2);
    const int vb0 = (int)(unsigned)(uintptr_t)V_lds + v_rd_base(lane);
    bf16x8 st_v0, st_v1, st_k0, st_k1;
    const unsigned svoff = (unsigned)(sr * PITCH + sc);
#define VMW() asm volatile("s_waitcnt vmcnt(0)" ::: "memory")
#define SLOAD_H(k0) do { const bf16* kt_ = Kg + (size_t)(k0) * PITCH; const bf16* vt_ = Vg + (size_t)(k0) * PITCH; \
        st_v0 = *(const GAS bf16x8*)(vt_ + svoff); st_v1 = *(const GAS bf16x8*)(vt_ + 32 * PITCH + svoff); st_k0 = *(const GAS bf16x8*)(kt_ + svoff); st_k1 = *(const GAS bf16x8*)(kt_ + 32 * PITCH + svoff); } while (0)
#define SWRITE_HK(bf) do { *(LAS bf16x8*)(K_lds + (bf) * SHM_K + kws) = st_k0; *(LAS bf16x8*)(K_lds + (bf) * SHM_K + kws + 32 * 256) = st_k1; } while (0)
#define SWRITE_HV(bf) do { *(LAS bf16x8*)(V_lds + (bf) * SHM_V + vst0) = st_v0; *(LAS bf16x8*)(V_lds + (bf) * SHM_V + vst1) = st_v1; } while (0)
#define SWRITE_H(bf) do { SWRITE_HV(bf); SWRITE_HK(bf); } while (0)
    SLOAD_H(0);
    unsigned sel = 0u;
    if (qb > 0) {
        float g[7];
#pragma unroll
        for (int n = 0; n < 7; ++n) g[n] = 0.f;
        const bf16* qrow = Qg + (size_t)(wid * 32) * PITCH + (unsigned)(r32 * PITCH + hi * 8); const float* kmp = km + hi * 8;
#pragma unroll 1
        for (int d0 = 0; d0 < 8; ++d0) {
            const v4u qw = *(const GAS v4u*)(qrow + d0 * 16);
            float qf[8];
            qf[0] = __uint_as_float(qw.x << 16); qf[1] = __uint_as_float(qw.x & 0xffff0000u); qf[2] = __uint_as_float(qw.y << 16); qf[3] = __uint_as_float(qw.y & 0xffff0000u);
            qf[4] = __uint_as_float(qw.z << 16); qf[5] = __uint_as_float(qw.z & 0xffff0000u); qf[6] = __uint_as_float(qw.w << 16); qf[7] = __uint_as_float(qw.w & 0xffff0000u);
#pragma unroll
            for (int n = 0; n < 7; ++n) if (n < qb) {
                const float* kp = kmp + (size_t)n * DM + d0 * 16;
                const f32x4 k0 = *(const GAS f32x4*)kp, k1 = *(const GAS f32x4*)(kp + 4);
                g[n] += (qf[0] * k0[0] + qf[1] * k0[1]) + (qf[2] * k0[2] + qf[3] * k0[3]) + (qf[4] * k1[0] + qf[5] * k1[1]) + (qf[6] * k1[2] + qf[7] * k1[3]);
            }
        }
#pragma unroll
        for (int n = 0; n < 7; ++n) g[n] += __shfl_xor(g[n], 32);
#pragma unroll
        for (int it = 0; it < 3; ++it) if (it < qb) {
            float best = -__builtin_inff(); int bi = 0;
#pragma unroll
            for (int n = 0; n < 7; ++n) if (n < qb) { const bool c = !((sel >> n) & 1u) && (g[n] > best); best = c ? g[n] : best; bi = c ? n : bi; }
            sel |= 1u << bi;
        }
    }
    asm volatile("" ::: "memory");
    bf16x8 qr[8];
#pragma unroll
    for (int d0 = 0; d0 < 8; ++d0) qr[d0] = *(const GAS bf16x8*)(Qg + (size_t)(wid * 32) * PITCH + ((unsigned)(r32 * PITCH + hi * 8) + d0 * 16));
    sel |= 1u << qb;
    VMW(); SWRITE_HK(0); SWRITE_HV(0);
    SLOAD_H(64);
    LDS_WAIT(); __syncthreads();
    const int qlo = qb * 256 + wid * 32, qm = qlo + r32 - 4 * hi;
    float m_reg = -1e30f, l_reg = 0.f; f32x16 o[4];
#pragma unroll
    for (int d = 0; d < 4; ++d)
#pragma unroll
        for (int r = 0; r < 16; ++r) o[d][r] = 0.f;
#define RESC(a) do { if (__any((a) < 1.f)) { if (hi == 0) al_l[r32] = (a); asm volatile("s_waitcnt lgkmcnt(0)" ::: "memory"); \
        _Pragma("unroll") for (int d_ = 0; d_ < 4; ++d_) _Pragma("unroll") for (int r = 0; r < 16; ++r) o[d_][r] *= al_l[crow(r, hi)]; } } while (0)
#define BASE0(t) ((((sel >> ((t) >> 2)) & 1u) != 0u) ? -slope2 * (float)(qm - (t) * 64) : -__builtin_inff())
#define MASKT(P0_, P1_, t) do { const int kb_ = (t) * 64; if (((t) >> 2) == qb && kb_ + 63 > qlo) mask_tile(P0_, P1_, qm - kb_); } while (0)
    f32x16 pA0, pA1, pB0, pB1; float mnA, mnB, alA, alB; bf16x8 pa0, pa1, pa2, pa3;
    SBAR(); qkt<0>(pA0, pA1, K_lds, r32, hi, qr, BASE0(0), slope2);
    MASKT(pA0, pA1, 0); partialSM(pA0, pA1, m_reg, mnA, alA);
    VMW(); SWRITE_H(1);
    LDS_WAIT(); __syncthreads();
#define HALF_STEP(PX0, PX1, mnX, alX, PY0, PY1, alY, t, KB, VB, SB) do { \
        SBAR(); qkt<KB>(PX0, PX1, K_lds, r32, hi, qr, BASE0(t), slope2); \
        finishSM(PY0, PY1, alY, l_reg, pa0, pa1, pa2, pa3); SBAR(); \
        if ((t) + 1 < NT) { SLOAD_H(((t) + 1) * 64); SBAR(); } \
        pv_tile<VB>(o, vb0, pa0, pa1, pa2, pa3); MASKT(PX0, PX1, (t)); partialSM(PX0, PX1, m_reg, mnX, alX); \
        LDS_WAIT(); __syncthreads(); \
        if ((t) + 1 < NT) { VMW(); SWRITE_H(SB); } \
        RESC(alX); LDS_WAIT(); __syncthreads(); } while (0)
    for (int t = 1; t + 1 < NT; t += 2) {
        HALF_STEP(pB0, pB1, mnB, alB, pA0, pA1, alA, t, 1, 0, 0);
        HALF_STEP(pA0, pA1, mnA, alA, pB0, pB1, alB, t + 1, 0, 1, 1);
    }
    SBAR(); qkt<1>(pB0, pB1, K_lds, r32, hi, qr, BASE0(NT - 1), slope2); SBAR();
    finishSM(pA0, pA1, alA, l_reg, pa0, pa1, pa2, pa3); SBAR();
    pv_tile<0>(o, vb0, pa0, pa1, pa2, pa3);
    MASKT(pB0, pB1, NT - 1); partialSM(pB0, pB1, m_reg, mnB, alB); RESC(alB);
    finishSM(pB0, pB1, alB, l_reg, pa0, pa1, pa2, pa3); SBAR();
    pv_tile<1>(o, vb0, pa0, pa1, pa2, pa3);
    if (hi == 0) li_l[r32] = l_reg;
    asm volatile("s_waitcnt lgkmcnt(0)" ::: "memory");
    float rli[16];
#pragma unroll
    for (int r = 0; r < 16; ++r) rli[r] = __builtin_amdgcn_rcpf(li_l[crow(r, hi)]);
    LDS_WAIT(); __syncthreads();
    {
        LAS unsigned short* stg = (LAS unsigned short*)(lds + wid * 8192);
#pragma unroll
        for (int r = 0; r < 16; ++r) { const int orow = crow(r, hi);
#pragma unroll
            for (int d0 = 0; d0 < 4; ++d0) stg[orow * 128 + d0 * 32 + r32] = (unsigned short)f2bf(o[d0][r] * rli[r]); }
        asm volatile("s_waitcnt lgkmcnt(0)" ::: "memory");
        int ln = lane; asm volatile("" : "+v"(ln));
#pragma unroll
        for (int i = 0; i < 8; ++i) { const int id = i * 64 + ln, row = id >> 4, ch = id & 15;
            const v4u v = *(const LAS v4u*)((LAS unsigned char*)stg + row * 256 + ch * 16);
            *(GAS v4u*)(Og + (size_t)(wid * 32) * DM + (unsigned)(row * DM + ch * 8)) = v; }
    }
    LDS_WAIT(); __syncthreads();
#undef VMW
#undef SLOAD_H
#undef SWRITE_HK
#undef SWRITE_HV
#undef SWRITE_H
#undef RESC
#undef BASE0
#undef MASKT
#undef HALF_STEP
}
#undef KSWZ
#undef SBAR
}

__device__ __forceinline__ void p6_attn(const Ptrs& P, LAS unsigned char* lds, int vcu, int G, int tid, int wave, int lane) {
    const bf16* QKV = (const bf16*)(P.ws + WS_QKV); bf16* ATT = (bf16*)(P.ws + WS_ATT); const float* kmean = (const float*)(P.ws + WS_KMEAN);
    for (int it = vcu; it < BATCH * NH * 4; it += G) {
        const int bh = it >> 2, s = it & 3, b = bh / NH, h = bh % NH;
        const float slope2 = exp2f(-8.0f * (float)(h + 1) / (float)NH) * 1.4426950408889634f;
        const bf16* Kg = QKV + (size_t)b * SEQ * att::PITCH + DM + h * HD; const bf16* Vg = Kg + DM;
        const float* km = kmean + (size_t)(b * NBLK) * DM + h * HD;
#pragma unroll 1
        for (int pass = 0; pass < 2; ++pass) {
            const int qb = pass == 0 ? s : 7 - s;
            const bf16* Qg = QKV + ((size_t)b * SEQ + qb * 256) * att::PITCH + h * HD;
            bf16* Og = ATT + ((size_t)b * SEQ + qb * 256) * DM + h * HD;
            att::moba_block(Qg, Kg, Vg, Og, km, qb, slope2, lds, tid, wave, lane);
        }
    }
}

__global__ void __launch_bounds__(NWAVES * 64, 2) mk_fwd(Args args) {
    extern __shared__ __attribute__((aligned(16))) unsigned char lds_raw[];
    LAS unsigned char* lds = (LAS unsigned char*)lds_raw;
    volatile LAS unsigned* MISC = (volatile LAS unsigned*)(lds + MISC_OFF);
    const int tid = threadIdx.x, lane = tid & 63, wave = __builtin_amdgcn_readfirstlane(tid >> 6);
    const int G = gridDim.x; const int bx = blockIdx.x; const int vcu = (G % 8 == 0) ? (bx % 8) * (G / 8) + bx / 8 : bx;
    Ptrs P;
#pragma unroll
    for (int i = 0; i < 21; ++i) P.in[i] = args.in[i];
    P.out = args.out; P.ws = args.ws;
    unsigned char* ws = args.ws;
    gu32* ctl = (gu32*)(ws + WS_CTL);
    for (int u = tid; u < (LDS_BYTES - LDSCTL_OFF) / 4; u += NWAVES * 64) ((LAS unsigned*)(lds + LDSCTL_OFF))[u] = 0u;
    __syncthreads();
    XcdBarrier bar = xcd_barrier_post((unsigned*)(ctl + CW_BAR) + args.li * XCD_BAR_WORDS, MISC + 8);
    const int lo = args.ph_lo, hi = args.ph_hi;
#define IN(k) (lo <= (k) && (k) < hi)
#define BOTH(k) (IN(k) && IN((k) + 1))
#define GRID_BAR() xcd_barrier(bar)
    float* ss1 = (float*)(ws + WS_SS); float* ss2 = ss1 + MTOK; float* ss3 = ss2 + MTOK; float* ss4 = ss3 + MTOK;
    float* kmean = (float*)(ws + WS_KMEAN);
    float* H = args.out; float* H2 = (float*)(ws + WS_H2);
    bf16* HB = (bf16*)(ws + WS_HB); bf16* Z = (bf16*)(ws + WS_Z); bf16* ACT = (bf16*)(ws + WS_ACT); bf16* QKV = (bf16*)(ws + WS_QKV); bf16* ATT = (bf16*)(ws + WS_ATT);

    if (IN(0)) { for (int item = vcu; item < 2 * NG; item += G) p0_s5_tables(P, lds, item, tid); p0_prologue(P, lds, vcu, G, wave, lane); if (BOTH(0)) GRID_BAR(); }
    if (IN(1)) { p1_s5(P, lds, vcu, G, tid, wave, lane); if (BOTH(1)) GRID_BAR(); }
    if (IN(2)) {
        pg8::Gemm g{Z, (const bf16*)(ws + WS_WGLU), MTOK, DM, DM}; pg8::StaticOrder S; S.init(MTOK, DM, G, bx);
        pg8::EpiGlu E{P.in[0], Z, P.in[11], H, HB, ss1};
        pg8::gemm_phase<pg8::EpiGlu, pg8::StaticOrder, true, true>(lds + RING_OFF, g, S, E);
        if (BOTH(2)) GRID_BAR();
    }
    if (IN(3)) {
        pg8::Gemm g{HB, (const bf16*)(ws + WS_WGU0), MTOK, 2 * FF, DM}; pg8::StaticOrder S; S.init(MTOK, 2 * FF, G, bx);
        pg8::EpiSwiGLU E{ss1, ACT};
        pg8::gemm_phase<pg8::EpiSwiGLU, pg8::StaticOrder, true, true>(lds + RING_OFF, g, S, E);
        if (BOTH(3)) GRID_BAR();
    }
    if (IN(4)) {
        pg8::Gemm g{ACT, (const bf16*)(ws + WS_WD0), MTOK, DM, FF}; pg8::StaticOrder S; S.init(MTOK, DM, G, bx);
        pg8::EpiRes E{H, H, HB, ss2};
        pg8::gemm_phase<pg8::EpiRes, pg8::StaticOrder, true, true>(lds + RING_OFF, g, S, E);
        if (BOTH(4)) GRID_BAR();
    }
    if (IN(5)) {
        pg8::Gemm g{HB, (const bf16*)(ws + WS_WQKV), MTOK, NQKV, DM}; pg8::StaticOrder S; S.init(MTOK, NQKV, G, bx);
        pg8::EpiQKV E{ss2, QKV, kmean};
        pg8::gemm_phase<pg8::EpiQKV, pg8::StaticOrder, true, true>(lds + RING_OFF, g, S, E);
        if (BOTH(5)) GRID_BAR();
    }
    if (IN(6)) { p6_attn(P, lds, vcu, G, tid, wave, lane); if (BOTH(6)) GRID_BAR(); }
    if (IN(7)) {
        pg8::Gemm g{ATT, (const bf16*)(ws + WS_WO), MTOK, DM, DM}; pg8::StaticOrder S; S.init(MTOK, DM, G, bx);
        pg8::EpiRes E{H, H, HB, ss3};
        pg8::gemm_phase<pg8::EpiRes, pg8::StaticOrder, true, true>(lds + RING_OFF, g, S, E);
        if (BOTH(7)) GRID_BAR();
    }
    if (IN(8)) {
        pg8::Gemm g{HB, (const bf16*)(ws + WS_WGU1), MTOK, 2 * FF, DM}; pg8::StaticOrder S; S.init(MTOK, 2 * FF, G, bx);
        pg8::EpiSwiGLU E{ss3, ACT};
        pg8::gemm_phase<pg8::EpiSwiGLU, pg8::StaticOrder, true, true>(lds + RING_OFF, g, S, E);
        if (BOTH(8)) GRID_BAR();
    }
    if (IN(9)) {
        pg8::Gemm g{ACT, (const bf16*)(ws + WS_WD1), MTOK, DM, FF}; pg8::StaticOrder S; S.init(MTOK, DM, G, bx);
        pg8::EpiRes E{H, H2, nullptr, ss4};
        pg8::gemm_phase<pg8::EpiRes, pg8::StaticOrder, true, true>(lds + RING_OFF, g, S, E);
        if (BOTH(9)) GRID_BAR();
    }
    if (IN(10)) { p10_final(P, vcu, G, wave, lane); }
#undef IN
#undef BOTH
#undef GRID_BAR
}

__device__ __forceinline__ float gelu_tanh(float y) {
    const float k0 = 0.7978845608028654f, k1 = 0.044715f;
    const float t = tanhf(k0 * (y + k1 * y * y * y));
    return 0.5f * y * (1.f + t);
}
__global__ __launch_bounds__(64) void s5_naive_k(const float* __restrict__ x, const float* __restrict__ rstd0, const float* __restrict__ g_mix,
                                                const float* __restrict__ lam_re, const float* __restrict__ lam_im, const float* __restrict__ log_dt,
                                                const float* __restrict__ b_re, const float* __restrict__ b_im, const float* __restrict__ c_re, const float* __restrict__ c_im,
                                                const float* __restrict__ d_skip, bf16* __restrict__ z) {
    const int b = blockIdx.x / NG, g = blockIdx.x % NG, p = threadIdx.x;
    const float lr = lam_re[g * NP + p], li = lam_im[g * NP + p], dt = expf(log_dt[g]);
    const float e = expf(lr * dt); float sn, cs; sincosf(li * dt, &sn, &cs);
    const float lbr = e * cs, lbi = e * sn;
    const float nr = lbr - 1.f, ni = lbi, den = lr * lr + li * li;
    const float cfr = (nr * lr + ni * li) / den, cfi = (ni * lr - nr * li) / den;
    float Bbr[NC], Bbi[NC], Cr[NC], Ci[NC], dsk[NC], gm[NC];
#pragma unroll
    for (int c = 0; c < NC; ++c) {
        const float br = b_re[(g * NP + p) * NC + c], bi = b_im[(g * NP + p) * NC + c];
        Bbr[c] = cfr * br - cfi * bi; Bbi[c] = cfr * bi + cfi * br;
        Cr[c] = c_re[(g * NC + c) * NP + p]; Ci[c] = c_im[(g * NC + c) * NP + p];
        dsk[c] = d_skip[g * NC + c]; gm[c] = g_mix[g * NC + c];
    }
    float sr = 0.f, si = 0.f;
    const float* xb = x + (size_t)b * SEQ * DM + g * NC;
    bf16* zb = z + (size_t)b * SEQ * DM + g * NC;
    for (int t = 0; t < SEQ; ++t) {
        float uc[NC]; const float rs = rstd0[b * SEQ + t];
#pragma unroll
        for (int c4 = 0; c4 < 4; ++c4) { const float4 v = *(const float4*)(xb + (size_t)t * DM + 4 * c4); uc[4 * c4] = v.x * rs * gm[4 * c4]; uc[4 * c4 + 1] = v.y * rs * gm[4 * c4 + 1]; uc[4 * c4 + 2] = v.z * rs * gm[4 * c4 + 2]; uc[4 * c4 + 3] = v.w * rs * gm[4 * c4 + 3]; }
        float bur = 0.f, bui = 0.f;
#pragma unroll
        for (int c = 0; c < NC; ++c) { bur += Bbr[c] * uc[c]; bui += Bbi[c] * uc[c]; }
        const float nsr = lbr * sr - lbi * si + bur, nsi = lbr * si + lbi * sr + bui;
        sr = nsr; si = nsi;
        float yv = 0.f;
#pragma unroll
        for (int c = 0; c < NC; ++c) {
            float v = Cr[c] * sr - Ci[c] * si;
#pragma unroll
            for (int o = 32; o > 0; o >>= 1) v += __shfl_xor(v, o);
            if (p == c) yv = v + dsk[c] * uc[c];
        }
        if (p < NC) zb[(size_t)t * DM + p] = (bf16)f2bf(gelu_tanh(yv));
    }
}
__device__ __forceinline__ float bf2f(bf16 v) { return __uint_as_float((unsigned)v << 16); }
__global__ __launch_bounds__(64) void attn_naive_k(const bf16* __restrict__ qkv, const float* __restrict__ kmean, bf16* __restrict__ out) {
    __shared__ float qs[HD];
    __shared__ float ps[4 * BLK];
    const int lane = threadIdx.x;
    const int t = blockIdx.x % SEQ, h = (blockIdx.x / SEQ) % NH, b = blockIdx.x / (SEQ * NH);
    const int own = t / BLK;
    const bf16* qp = qkv + ((size_t)b * SEQ + t) * NQKV + h * HD;
    qs[lane] = bf2f(qp[lane]); qs[lane + 64] = bf2f(qp[lane + 64]);
    __syncthreads();
    float gate = -INFINITY;
    if (lane < own) { const float* km = kmean + ((size_t)(b * NBLK + lane)) * DM + h * HD; float s = 0.f; for (int d = 0; d < HD; ++d) s += qs[d] * km[d]; gate = s; }
    float gv[NBLK];
#pragma unroll
    for (int n = 0; n < NBLK; ++n) gv[n] = __shfl(gate, n);
    unsigned selmask = 0u;
    const int ksel = own < 3 ? own : 3;
    for (int j = 0; j < ksel; ++j) {
        int best = -1; float bvv = -INFINITY;
#pragma unroll
        for (int n = 0; n < NBLK; ++n) if (n < own && gv[n] > bvv) { bvv = gv[n]; best = n; }
#pragma unroll
        for (int n = 0; n < NBLK; ++n) if (n == best) gv[n] = -INFINITY;
        selmask |= 1u << best;
    }
    selmask |= 1u << own;
    const float slope2 = exp2f(-8.0f * (float)(h + 1) / (float)NH) * 1.4426950408889634f;
    float mx = -INFINITY;
    int j = 0;
    for (int blk = 0; blk <= own; ++blk) {
        if (!((selmask >> blk) & 1u)) continue;
        for (int i = 0; i < 4; ++i) {
            const int s = lane + 64 * i, pos = blk * BLK + s;
            float sc = -INFINITY;
            if (pos <= t) {
                const bf16* kp = qkv + ((size_t)b * SEQ + pos) * NQKV + DM + h * HD; float dsum = 0.f;
                for (int d = 0; d < HD; d += 2) { const unsigned w = *(const unsigned*)(kp + d); dsum += qs[d] * __uint_as_float(w << 16) + qs[d + 1] * __uint_as_float(w & 0xffff0000u); }
                sc = dsum - slope2 * (float)(t - pos);
            }
            ps[j * BLK + s] = sc; mx = fmaxf(mx, sc);
        }
        ++j;
    }
    const int nsel = j;
#pragma unroll
    for (int o = 32; o > 0; o >>= 1) mx = fmaxf(mx, __shfl_xor(mx, o));
    float sum = 0.f;
    for (int jj = 0; jj < nsel; ++jj)
        for (int i = 0; i < 4; ++i) { const int s = lane + 64 * i; const float e = exp2f(ps[jj * BLK + s] - mx); ps[jj * BLK + s] = e; sum += e; }
#pragma unroll
    for (int o = 32; o > 0; o >>= 1) sum += __shfl_xor(sum, o);
    __syncthreads();
    const float inv = 1.f / sum;
    float o0 = 0.f, o1 = 0.f;
    j = 0;
    for (int blk = 0; blk <= own; ++blk) {
        if (!((selmask >> blk) & 1u)) continue;
        const int lim = (blk == own) ? (t - own * BLK + 1) : BLK;
        const bf16* vp = qkv + ((size_t)b * SEQ + blk * BLK) * NQKV + 2 * DM + h * HD;
        for (int s = 0; s < lim; ++s) { const float pp = ps[j * BLK + s]; o0 += pp * bf2f(vp[(size_t)s * NQKV + lane]); o1 += pp * bf2f(vp[(size_t)s * NQKV + lane + 64]); }
        ++j;
    }
    bf16* op = out + ((size_t)b * SEQ + t) * DM + h * HD;
    op[lane] = (bf16)f2bf(o0 * inv); op[lane + 64] = (bf16)f2bf(o1 * inv);
}

extern "C" void kernel_launch(void* const* d_in, const int* in_sizes, int n_in, void* d_out, int out_size, void* d_ws, size_t ws_size, hipStream_t stream) {
    static int grid = 0;
    if (grid == 0) {
        if (n_in != 21 || in_sizes[0] != MTOK * DM || out_size != MTOK * DM || ws_size < WS_END) { fprintf(stderr, "kernel_launch: shape/workspace mismatch (n_in %d, ws %zu, need %zu)\n", n_in, ws_size, (size_t)WS_END); grid = -1; return; }
        int dev = 0, cus = 0, per_cu = 0;
        if (hipGetDevice(&dev) != hipSuccess || hipDeviceGetAttribute(&cus, hipDeviceAttributeMultiprocessorCount, dev) != hipSuccess) { grid = -1; return; }
        if (hipFuncSetAttribute((const void*)mk_fwd, hipFuncAttributeMaxDynamicSharedMemorySize, LDS_BYTES) != hipSuccess) { fprintf(stderr, "kernel_launch: hipFuncSetAttribute failed\n"); grid = -1; return; }
        if (hipOccupancyMaxActiveBlocksPerMultiprocessor(&per_cu, (const void*)mk_fwd, NWAVES * 64, LDS_BYTES) != hipSuccess || per_cu < 1) fprintf(stderr, "kernel_launch: occupancy query reports %d\n", per_cu);
        (void)hipGetLastError();
        grid = cus;
    }
    if (grid < 0) return;
    (void)hipMemsetAsync((char*)d_ws + WS_CTL, 0, CTL_ZERO_BYTES, stream);
    Args a{};
    for (int i = 0; i < 21; ++i) a.in[i] = (const float*)d_in[i];
    a.out = (float*)d_out; a.ws = (unsigned char*)d_ws;
    unsigned char* ws = (unsigned char*)d_ws;
    int li = 0;
#define LAUNCH(LO, HI) do { a.ph_lo = (LO); a.ph_hi = (HI); a.li = li++; hipLaunchKernelGGL(mk_fwd, dim3(grid), dim3(NWAVES * 64), LDS_BYTES, stream, a); } while (0)
    LAUNCH(0, 11);
#undef LAUNCH
}
```
